# Optimizing an MI355X kernel written in HIP

```python
import functools
import math
import jax
import jax.numpy as jnp
from jax import lax
import numpy as np

D_MODEL = 1024
BATCH = 4
SEQ = 8192
DEPTH = 1
DEC_BATCH = 8
DEC_SEQ = 64
PAST_LEN = 1024

CHUNK = 64
HEAD_DIM = 64
N_HEADS_A = 8
N_HEADS_IDX = 4
IDX_DIM = 64
TOPK_MAX = 256
IDX_QBLK = CHUNK
IDX_SCALE = (IDX_DIM * N_HEADS_IDX) ** -0.5
N_HEADS_B = 8
BAND_CHUNKS = 8
REL_BACK = 128
REL_SIZE = REL_BACK + CHUNK
T5_BUCKETS = 32
T5_MAX_DIST = 128
D_FF = 2816
LN_EPS = 1e-5
NEG_INF = -1e30
WIDTH_A = N_HEADS_A * HEAD_DIM
WIDTH_B = N_HEADS_B * HEAD_DIM
IN_SIZES = (WIDTH_A, WIDTH_A, WIDTH_A, N_HEADS_IDX * IDX_DIM, IDX_DIM, N_HEADS_IDX,
            WIDTH_B, WIDTH_B, WIDTH_B, D_MODEL, D_MODEL)
N_IN = sum(IN_SIZES)

kernel_name = 'chunk_stream_dsa_band_hybrid'


def _layer_norm(x, g, b):
    x32 = x.astype(jnp.float32)
    mu = x32.mean(-1, keepdims=True)
    var = jnp.square(x32 - mu).mean(-1, keepdims=True)
    y = (x32 - mu) * lax.rsqrt(var + LN_EPS) * g.astype(jnp.float32) + b.astype(jnp.float32)
    return y.astype(x.dtype)


def _swiglu(x, wi, wo):
    a, u = jnp.split(x @ wi, 2, axis=-1)
    return (jax.nn.silu(a) * u) @ wo


def _t5_bucket(rel):
    half = T5_BUCKETS // 2
    exact = half // 2
    n = jnp.abs(rel)
    log_ratio = jnp.log(jnp.maximum(n, 1).astype(jnp.float32) / exact) / math.log(T5_MAX_DIST / exact)
    large = jnp.minimum(exact + (log_ratio * (half - exact)).astype(jnp.int32), half - 1)
    return (rel > 0).astype(jnp.int32) * half + jnp.where(n < exact, n, large)


def _split_in(h, w_in):
    b, t = h.shape[:2]
    z = h @ w_in
    offs, acc = [], 0
    for s in IN_SIZES[:-1]:
        acc += s
        offs.append(acc)
    qa, ka, va, qi, ki, wi, qb, kb, vb, ga, gb = jnp.split(z, offs, axis=-1)
    heads = lambda a, n: a.reshape(b, t, n, -1)
    return (heads(qa, N_HEADS_A), heads(ka, N_HEADS_A), heads(va, N_HEADS_A),
            heads(qi, N_HEADS_IDX), ki, wi,
            heads(qb, N_HEADS_B), heads(kb, N_HEADS_B), heads(vb, N_HEADS_B), ga, gb)


def _dsa_attend(q, qi, wi, q_pos, k, v, ki, k_pos, n_sel, t5_bias):
    f32 = jnp.float32
    dots = jnp.einsum('bqhd,bsd->bqhs', qi, ki).astype(f32)
    score = jnp.einsum('bqh,bqhs->bqs', wi.astype(f32), jax.nn.relu(dots)) * IDX_SCALE
    q_chunk = q_pos // CHUNK
    adm = (k_pos // CHUNK)[None, :] <= q_chunk[:, None]
    score = jnp.where(adm[None], score, -jnp.inf)
    _, sel = lax.top_k(score, n_sel)
    sel_pos = k_pos[sel]
    valid = (sel_pos // CHUNK) <= q_chunk[None, :, None]
    kg = jax.vmap(lambda kb_, ib: kb_[ib])(k, sel)
    vg = jax.vmap(lambda vb_, ib: vb_[ib])(v, sel)
    bias = t5_bias.T[_t5_bucket(sel_pos - q_pos[None, :, None])]
    logits = jnp.einsum('bqhd,bqkhd->bqkh', q, kg).astype(f32) * (HEAD_DIM ** -0.5) + bias.astype(f32)
    logits = jnp.where(valid[..., None], logits, NEG_INF)
    p = jax.nn.softmax(logits, axis=2).astype(v.dtype)
    return jnp.einsum('bqkh,bqkhd->bqhd', p, vg)


def _dsa_prompt(q, qi, wi, k, v, ki, t5_bias):
    b, t = q.shape[:2]
    nb = t // IDX_QBLK
    n_sel = min(TOPK_MAX, t // 4)
    pos = jnp.arange(t, dtype=jnp.int32)
    blk = lambda a: jnp.moveaxis(a.reshape((b, nb, IDX_QBLK) + a.shape[2:]), 1, 0)

    def one(args):
        qb, qib, wib, pb = args
        return _dsa_attend(qb, qib, wib, pb, k, v, ki, pos, n_sel, t5_bias)

    out = lax.map(one, (blk(q), blk(qi), blk(wi), pos.reshape(nb, IDX_QBLK)))
    return jnp.moveaxis(out, 0, 1).reshape(b, t, N_HEADS_A, HEAD_DIM)


def _band_attend(q, q_pos, k, v, k_pos, rel_bias):
    f32 = jnp.float32
    qc = q_pos // CHUNK
    kc = k_pos // CHUNK
    mask = ((k_pos >= 0)[None, :] & (kc[None, :] <= qc[:, None])
            & (kc[None, :] >= qc[:, None] - BAND_CHUNKS))
    ridx = jnp.clip(k_pos[None, :] - q_pos[:, None], -REL_BACK, CHUNK - 1) + REL_BACK
    bias = rel_bias[:, ridx]
    logits = jnp.einsum('bqhd,bkhd->bhqk', q, k).astype(f32) * (HEAD_DIM ** -0.5) + bias[None].astype(f32)
    logits = jnp.where(mask[None, None], logits, NEG_INF)
    p = jax.nn.softmax(logits, axis=-1).astype(v.dtype)
    return jnp.einsum('bhqk,bkhd->bqhd', p, v)


def _band_prompt(q, k, v, rel_bias):
    b, t = q.shape[:2]
    nc = t // CHUNK
    pad = BAND_CHUNKS * CHUNK
    kp = jnp.pad(k, ((0, 0), (pad, 0), (0, 0), (0, 0)))
    vp = jnp.pad(v, ((0, 0), (pad, 0), (0, 0), (0, 0)))
    qc = jnp.moveaxis(q.reshape(b, nc, CHUNK, N_HEADS_B, HEAD_DIM), 1, 0)

    def one(args):
        c, qb = args
        start = c * CHUNK
        kb = lax.dynamic_slice_in_dim(kp, start, pad + CHUNK, axis=1)
        vb = lax.dynamic_slice_in_dim(vp, start, pad + CHUNK, axis=1)
        q_pos = start + jnp.arange(CHUNK, dtype=jnp.int32)
        k_pos = start - pad + jnp.arange(pad + CHUNK, dtype=jnp.int32)
        return _band_attend(qb, q_pos, kb, vb, k_pos, rel_bias)

    out = lax.map(one, (jnp.arange(nc, dtype=jnp.int32), qc))
    return jnp.moveaxis(out, 0, 1).reshape(b, t, N_HEADS_B, HEAD_DIM)


def _prompt_mixer(h, w_in, t5_bias, rel_bias):
    qa, ka, va, qi, ki, wi, qb, kb, vb, ga, gb = _split_in(h, w_in)
    oa = _dsa_prompt(qa, qi, wi, ka, va, ki, t5_bias)
    ob = _band_prompt(qb, kb, vb, rel_bias)
    keep = min(BAND_CHUNKS * CHUNK, h.shape[1])
    return oa, ob, ga, gb, (ka, va, ki, kb[:, -keep:], vb[:, -keep:])


def _sample_mixer(h, w_in, t5_bias, rel_bias, c_k_a, c_v_a, c_kidx_a, c_k_b, c_v_b):
    qa, ka, va, qi, ki, wi, qb, kb, vb, ga, gb = _split_in(h, w_in)
    past, n = c_k_a.shape[1], h.shape[1]
    q_pos = past + jnp.arange(n, dtype=jnp.int32)
    ka_all = jnp.concatenate([c_k_a.astype(ka.dtype), ka], axis=1)
    va_all = jnp.concatenate([c_v_a.astype(va.dtype), va], axis=1)
    ki_all = jnp.concatenate([c_kidx_a.astype(ki.dtype), ki], axis=1)
    ka_pos = jnp.arange(past + n, dtype=jnp.int32)
    n_sel = min(TOPK_MAX, (past + n) // 4)
    oa = _dsa_attend(qa, qi, wi, q_pos, ka_all, va_all, ki_all, ka_pos, n_sel, t5_bias)
    band = c_k_b.shape[1]
    kb_all = jnp.concatenate([c_k_b.astype(kb.dtype), kb], axis=1)
    vb_all = jnp.concatenate([c_v_b.astype(vb.dtype), vb], axis=1)
    kb_pos = (past - band) + jnp.arange(band + n, dtype=jnp.int32)
    ob = _band_attend(qb, q_pos, kb_all, vb_all, kb_pos, rel_bias)
    return oa, ob, ga, gb, (ka, va, ki, kb_all[:, -band:], vb_all[:, -band:])


def _layer(x, mixer, ln1_g, ln1_b, ffn1_wi, ffn1_wo, ln2_g, ln2_b, w_branch_a, w_branch_b,
           w_out, ln3_g, ln3_b, ffn2_wi, ffn2_wo):
    alpha = (2.0 * DEPTH) ** 0.25
    h = _layer_norm(alpha * x + 0.5 * _swiglu(x, ffn1_wi, ffn1_wo), ln1_g, ln1_b)
    oa, ob, ga, gb, states = mixer(h)
    b, t = h.shape[:2]
    ya = oa.reshape(b, t, WIDTH_A) @ w_branch_a
    yb = ob.reshape(b, t, WIDTH_B) @ w_branch_b
    mix = (jax.nn.sigmoid(ga) * ya + jax.nn.sigmoid(gb) * yb) @ w_out
    h = _layer_norm(alpha * h + mix, ln2_g, ln2_b)
    h = _layer_norm(alpha * h + 0.5 * _swiglu(h, ffn2_wi, ffn2_wo), ln3_g, ln3_b)
    return h, states


def setup_inputs(seed: int = 0) -> dict:
    key = jax.random.key(seed)
    ks = jax.random.split(key, 24)
    f32 = jnp.float32
    beta = (8.0 * DEPTH) ** -0.25
    band = min(BAND_CHUNKS * CHUNK, PAST_LEN)

    def nrm(k, shape, scale):
        return jax.random.normal(k, shape, f32) * scale

    col_scale = jnp.concatenate([jnp.full((s,), beta if i in (2, 8) else 1.0, f32)
                                 for i, s in enumerate(IN_SIZES)])
    return {
        'x_prompt': nrm(ks[0], (BATCH, SEQ, D_MODEL), 1.0),
        'x_sample': nrm(ks[1], (DEC_BATCH, DEC_SEQ, D_MODEL), 1.0),
        'cache_k_a': nrm(ks[2], (DEPTH, DEC_BATCH, PAST_LEN, N_HEADS_A, HEAD_DIM), 1.0),
        'cache_v_a': nrm(ks[3], (DEPTH, DEC_BATCH, PAST_LEN, N_HEADS_A, HEAD_DIM), 1.0),
        'cache_kidx_a': nrm(ks[4], (DEPTH, DEC_BATCH, PAST_LEN, IDX_DIM), 1.0),
        'cache_k_b': nrm(ks[5], (DEPTH, DEC_BATCH, band, N_HEADS_B, HEAD_DIM), 1.0),
        'cache_v_b': nrm(ks[6], (DEPTH, DEC_BATCH, band, N_HEADS_B, HEAD_DIM), 1.0),
        't5_bias': nrm(ks[7], (N_HEADS_A, T5_BUCKETS), 0.5),
        'ln1_g': 1.0 + nrm(ks[8], (DEPTH, D_MODEL), 0.05),
        'ln1_b': nrm(ks[9], (DEPTH, D_MODEL), 0.02),
        'ffn1_wi': nrm(ks[10], (DEPTH, D_MODEL, 2 * D_FF), D_MODEL ** -0.5),
        'ffn1_wo': nrm(ks[11], (DEPTH, D_FF, D_MODEL), beta * D_FF ** -0.5),
        'ln2_g': 1.0 + nrm(ks[12], (DEPTH, D_MODEL), 0.05),
        'ln2_b': nrm(ks[13], (DEPTH, D_MODEL), 0.02),
        'w_in': nrm(ks[14], (DEPTH, D_MODEL, N_IN), D_MODEL ** -0.5) * col_scale,
        'rel_bias_b': nrm(ks[15], (DEPTH, N_HEADS_B, REL_SIZE), 0.5),
        'w_branch_a': nrm(ks[16], (DEPTH, WIDTH_A, D_MODEL), beta * WIDTH_A ** -0.5),
        'w_branch_b': nrm(ks[17], (DEPTH, WIDTH_B, D_MODEL), beta * WIDTH_B ** -0.5),
        'w_out': nrm(ks[18], (DEPTH, D_MODEL, D_MODEL), beta * D_MODEL ** -0.5),
        'ln3_g': 1.0 + nrm(ks[19], (DEPTH, D_MODEL), 0.05),
        'ln3_b': nrm(ks[20], (DEPTH, D_MODEL), 0.02),
        'ffn2_wi': nrm(ks[21], (DEPTH, D_MODEL, 2 * D_FF), D_MODEL ** -0.5),
        'ffn2_wo': nrm(ks[22], (DEPTH, D_FF, D_MODEL), beta * D_FF ** -0.5),
    }


def reference(x_prompt, x_sample, cache_k_a, cache_v_a, cache_kidx_a, cache_k_b, cache_v_b,
              t5_bias, ln1_g, ln1_b, ffn1_wi, ffn1_wo, ln2_g, ln2_b, w_in, rel_bias_b,
              w_branch_a, w_branch_b, w_out, ln3_g, ln3_b, ffn2_wi, ffn2_wo):
    y_prompt, y_sample = x_prompt, x_sample
    st_p, st_s = [], []
    for l in range(DEPTH):
        shared = (ln1_g[l], ln1_b[l], ffn1_wi[l], ffn1_wo[l], ln2_g[l], ln2_b[l],
                  w_branch_a[l], w_branch_b[l], w_out[l], ln3_g[l], ln3_b[l],
                  ffn2_wi[l], ffn2_wo[l])
        mix_p = functools.partial(_prompt_mixer, w_in=w_in[l], t5_bias=t5_bias,
                                  rel_bias=rel_bias_b[l])
        mix_s = functools.partial(_sample_mixer, w_in=w_in[l], t5_bias=t5_bias,
                                  rel_bias=rel_bias_b[l], c_k_a=cache_k_a[l],
                                  c_v_a=cache_v_a[l], c_kidx_a=cache_kidx_a[l],
                                  c_k_b=cache_k_b[l], c_v_b=cache_v_b[l])
        y_prompt, sp = _layer(y_prompt, mix_p, *shared)
        y_sample, ss = _layer(y_sample, mix_s, *shared)
        st_p.append(sp)
        st_s.append(ss)
    new_k_a_prompt = jnp.stack([s[0] for s in st_p])
    new_v_a_prompt = jnp.stack([s[1] for s in st_p])
    new_kidx_a_prompt = jnp.stack([s[2] for s in st_p])
    new_k_b_prompt = jnp.stack([s[3] for s in st_p])
    new_v_b_prompt = jnp.stack([s[4] for s in st_p])
    new_k_a_sample = jnp.stack([s[0] for s in st_s])
    new_v_a_sample = jnp.stack([s[1] for s in st_s])
    new_kidx_a_sample = jnp.stack([s[2] for s in st_s])
    new_k_b_sample = jnp.stack([s[3] for s in st_s])
    new_v_b_sample = jnp.stack([s[4] for s in st_s])
    return (y_prompt, y_sample, new_k_a_prompt, new_v_a_prompt, new_kidx_a_prompt,
            new_k_b_prompt, new_v_b_prompt, new_k_a_sample, new_v_a_sample,
            new_kidx_a_sample, new_k_b_sample, new_v_b_sample)
```

```cpp
#include <hip/hip_runtime.h>
#include <cstdio>
#include <cstdint>

#ifndef MK_N_LAUNCHES
#define MK_N_LAUNCHES 13
#endif

constexpr int DM = 1024, NB_P = 4, SEQ = 8192, NB_S = 8, DSEQ = 64, PAST = 1024, BANDC = 512;
constexpr int MP = NB_P * SEQ;
constexpr int MS = NB_S * DSEQ;
constexpr int MT = MP + MS;
constexpr int DFF = 2816, NUP = 2 * DFF  , NIN = 5444, NINP = 5632;
constexpr int WA = 512;
constexpr float ALPHA = 1.189207115002721f;
constexpr float LN_EPS = 1e-5f;
constexpr float LOG2E = 1.4426950408889634f;
constexpr float C2 = 0.125f * LOG2E;
constexpr size_t O_Y = 0;
constexpr size_t O_KA_P = (size_t)MT * DM;
constexpr size_t O_VA_P = O_KA_P + (size_t)MP * WA;
constexpr size_t O_KI_P = O_VA_P + (size_t)MP * WA;
constexpr size_t O_KB_P = O_KI_P + (size_t)MP * 64;
constexpr size_t O_VB_P = O_KB_P + (size_t)NB_P * BANDC * WA;
constexpr size_t O_KA_S = O_VB_P + (size_t)NB_P * BANDC * WA;
constexpr size_t O_VA_S = O_KA_S + (size_t)MS * WA;
constexpr size_t O_KI_S = O_VA_S + (size_t)MS * WA;
constexpr size_t O_KB_S = O_KI_S + (size_t)MS * 64;
constexpr size_t O_VB_S = O_KB_S + (size_t)NB_S * BANDC * WA;
constexpr size_t O_END = O_VB_S + (size_t)NB_S * BANDC * WA;
static_assert(O_END == 76578816, "output size");

namespace pg8 {
#define PG8_LAS __attribute__((address_space(3)))
typedef unsigned short bf16_t;
typedef short bf16x8 __attribute__((ext_vector_type(8)));
typedef float f32x4 __attribute__((ext_vector_type(4)));
typedef unsigned u32x4 __attribute__((ext_vector_type(4)));
constexpr int BM = 256, BK = 64, HALF = 128, HTB = HALF * BK * 2  , STAGE_BYTES = 8 * HTB, NXCD = 8, WGM = 8;

__host__ __device__ __forceinline__ int lds_byte(int r, int c) { const int st = (r >> 4) * 2 + (c >> 5), rr = r & 15, cc = c & 31, ob = rr * 64 + cc * 2; return st * 1024 + (ob ^ (((ob >> 9) & 1) << 5)); }
__host__ __device__ __forceinline__ void stage_rc(int b, int& R, int& C) { const int st = b / 1024, sb = b % 1024, swz = sb ^ (((sb >> 9) & 1) << 5); R = (st >> 1) * 16 + swz / 64; C = (st & 1) * 32 + (swz % 64) / 2; }
__host__ __device__ __forceinline__ int perm32(int rho) { const int n = rho >> 4, i = rho & 15; return 8 * (i >> 2) + 4 * n + (i & 3); }

struct Unit { int pm, pn; };
struct Gemm { const bf16_t* A; const bf16_t* Bt; int M, N, K; };

struct StaticOrder {
    int nM, nN, nwg, G, c;
    __host__ __device__ void init(int M, int N, int G_, int c_) { nM = M / BM; nN = N / BM; nwg = nM * nN; G = G_; c = c_; }
    __host__ __device__ bool next(int i, Unit& u) const {
        const long L = (long)i * G + c; if (L >= nwg) return false;
        int wgid = (int)L; { const int q = nwg / NXCD, r = nwg % NXCD, xcd = wgid % NXCD, off = wgid / NXCD; wgid = (xcd < r ? xcd * (q + 1) : r * (q + 1) + (xcd - r) * q) + off; }
        const int nig = WGM * nN, gid = wgid / nig, fm = gid * WGM, gsz = (nM - fm) < WGM ? (nM - fm) : WGM;
        u.pm = fm + ((wgid % nig) % gsz); u.pn = (wgid % nig) / gsz; return true;
    }
    __device__ __forceinline__ void a_ready(const Unit&) const {}
    __device__ __forceinline__ void done(const Unit&) const {}
};

typedef float f32x2_cv __attribute__((ext_vector_type(2))); typedef __bf16 bf16x2_cv __attribute__((ext_vector_type(2)));
__device__ __forceinline__ unsigned cvt_pk_bf16(float lo, float hi) { const f32x2_cv v = {lo, hi}; const bf16x2_cv b = __builtin_convertvector(v, bf16x2_cv); return __builtin_bit_cast(unsigned, b); }
typedef float f32x2 __attribute__((ext_vector_type(2)));

typedef unsigned u32x2 __attribute__((ext_vector_type(2)));
__device__ __forceinline__ float bf2f(unsigned short b) { return __uint_as_float((unsigned)b << 16); }
__device__ __forceinline__ float sigmoidf_fast(float x) { return __builtin_amdgcn_rcpf(1.0f + __builtin_amdgcn_exp2f(-x * LOG2E)); }
__device__ __forceinline__ f32x4 unpack_lo(u32x4 w) { return (f32x4){__uint_as_float(w.x << 16), __uint_as_float(w.x & 0xffff0000u), __uint_as_float(w.y << 16), __uint_as_float(w.y & 0xffff0000u)}; }
__device__ __forceinline__ f32x4 unpack_hi(u32x4 w) { return (f32x4){__uint_as_float(w.z << 16), __uint_as_float(w.z & 0xffff0000u), __uint_as_float(w.w << 16), __uint_as_float(w.w & 0xffff0000u)}; }
__device__ __forceinline__ u32x4 pack8(f32x4 v0, f32x4 v1) { u32x4 w; w.x = cvt_pk_bf16(v0[0], v0[1]); w.y = cvt_pk_bf16(v0[2], v0[3]); w.z = cvt_pk_bf16(v1[0], v1[1]); w.w = cvt_pk_bf16(v1[2], v1[3]); return w; }

struct EpiSwiglu {
    static constexpr bool PERM = true, AFTER_DRAIN = false;
    bf16_t* H;
    __device__ __forceinline__ void operator()(const f32x4 (&acc)[2][2][4][2], const Unit& u, int wr, int wc, int fr, int fq) const {
        const int row0 = u.pm * BM + wr * 64 + fr, col0 = u.pn * 128 + wc * 32 + 8 * fq;
#pragma unroll
        for (int ai = 0; ai < 2; ++ai)
#pragma unroll
            for (int m = 0; m < 4; ++m) {
                f32x4 h[2];
#pragma unroll
                for (int n = 0; n < 2; ++n) { const f32x4 a = acc[ai][0][m][n], g = acc[ai][1][m][n];
#pragma unroll
                    for (int j = 0; j < 4; ++j) h[n][j] = a[j] * sigmoidf_fast(a[j]) * g[j]; }
                *(u32x4*)(H + (size_t)(row0 + ai * HALF + m * 16) * DFF + col0) = pack8(h[0], h[1]);
            }
    }
};

template <int RES> struct EpiResF32 {
    static constexpr bool PERM = false, AFTER_DRAIN = false;
    const float* xp; const float* xs; const bf16_t* rb; float* out; float alpha, scale;
    __device__ __forceinline__ void operator()(const f32x4 (&acc)[2][2][4][2], const Unit& u, int wr, int wc, int fr, int fq) const {
        const int row0 = u.pm * BM + wr * 64 + fr, col0 = u.pn * BM + wc * 32 + 4 * fq;
#pragma unroll
        for (int ai = 0; ai < 2; ++ai)
#pragma unroll
            for (int m = 0; m < 4; ++m) { const int row = row0 + ai * HALF + m * 16;
                const float* xr = (row < MP) ? xp + (size_t)row * DM : xs + (size_t)(row - MP) * DM;
#pragma unroll
                for (int bj = 0; bj < 2; ++bj)
#pragma unroll
                    for (int n = 0; n < 2; ++n) { const int c = col0 + bj * HALF + n * 16; f32x4 r;
                        if (RES == 0) r = *(const f32x4*)(xr + c);
                        else { const u32x2 w = *(const u32x2*)(rb + (size_t)row * DM + c); r = (f32x4){__uint_as_float(w.x << 16), __uint_as_float(w.x & 0xffff0000u), __uint_as_float(w.y << 16), __uint_as_float(w.y & 0xffff0000u)}; }
                        *(f32x4*)(out + (size_t)row * DM + c) = r * alpha + acc[ai][bj][m][n] * scale; }
            }
    }
};

template <int ADD> struct EpiGate {
    static constexpr bool PERM = true, AFTER_DRAIN = false;
    const bf16_t* G; const bf16_t* PREV; bf16_t* OUT;
    __device__ __forceinline__ void operator()(const f32x4 (&acc)[2][2][4][2], const Unit& u, int wr, int wc, int fr, int fq) const {
        const int row0 = u.pm * BM + wr * 64 + fr, col0 = u.pn * BM + wc * 32 + 8 * fq;
#pragma unroll
        for (int ai = 0; ai < 2; ++ai)
#pragma unroll
            for (int m = 0; m < 4; ++m)
#pragma unroll
                for (int bj = 0; bj < 2; ++bj) { const size_t off = (size_t)(row0 + ai * HALF + m * 16) * DM + col0 + bj * HALF;
                    const u32x4 g = *(const u32x4*)(G + off);
                    f32x4 v0 = unpack_lo(g) * acc[ai][bj][m][0], v1 = unpack_hi(g) * acc[ai][bj][m][1];
                    if (ADD) { const u32x4 p = *(const u32x4*)(PREV + off); v0 += unpack_lo(p); v1 += unpack_hi(p); }
                    *(u32x4*)(OUT + off) = pack8(v0, v1); }
    }
};

struct EpiWin {
    static constexpr bool PERM = true, AFTER_DRAIN = false;
    bf16_t *QA, *KA, *VA, *QB, *KB, *VB, *GA, *GB, *QI, *KI; float* WX; float* out;
    __device__ __forceinline__ void operator()(const f32x4 (&acc)[2][2][4][2], const Unit& u, int wr, int wc, int fr, int fq) const {
        const int pn = u.pn, row0 = u.pm * BM + wr * 64 + fr, cl = wc * 32 + 8 * fq;
        const bool sample = (u.pm >= MP / BM);
        if (pn < 12) {
            const int grp = pn >> 1;
            bf16_t* dst = grp == 0 ? QA : grp == 1 ? KA : grp == 2 ? VA : grp == 3 ? QB : grp == 4 ? KB : VB;
            const float sc = (grp == 0 || grp == 3) ? C2 : 1.0f;
            const int cb = (pn & 1) * 256 + cl;
            const bool fa = (grp == 1 || grp == 2), fb = (grp == 4 || grp == 5);
            const bool wf = fa || (fb && (sample || (u.pm & 31) >= 30));
            size_t obase = 0;
            if (fa) obase = sample ? (grp == 1 ? O_KA_S : O_VA_S) : (grp == 1 ? O_KA_P : O_VA_P);
            if (fb) obase = sample ? (grp == 4 ? O_KB_S : O_VB_S) : (grp == 4 ? O_KB_P : O_VB_P);
#pragma unroll
            for (int ai = 0; ai < 2; ++ai)
#pragma unroll
                for (int m = 0; m < 4; ++m) { const int row = row0 + ai * HALF + m * 16;
                    size_t orow = 0;
                    if (fa) orow = sample ? (size_t)(row - MP) : (size_t)row;
                    if (fb) { if (sample) { const int s = row - MP; orow = (size_t)((s >> 6) * BANDC + (BANDC - DSEQ) + (s & 63)); } else { orow = (size_t)((row >> 13) * BANDC + ((row & (SEQ - 1)) - (SEQ - BANDC))); } }
#pragma unroll
                    for (int bj = 0; bj < 2; ++bj) { const f32x4 v0 = acc[ai][bj][m][0], v1 = acc[ai][bj][m][1];
                        *(u32x4*)(dst + (size_t)row * WA + cb + bj * HALF) = pack8(v0 * sc, v1 * sc);
                        if (wf) { float* o = out + obase + orow * WA + cb + bj * HALF; *(f32x4*)o = v0; *(f32x4*)(o + 4) = v1; } }
                }
        } else if (pn < 20) {
            bf16_t* dst = pn < 16 ? GA : GB; const int cb = ((pn - 12) & 3) * 256 + cl;
#pragma unroll
            for (int ai = 0; ai < 2; ++ai)
#pragma unroll
                for (int m = 0; m < 4; ++m) { const int row = row0 + ai * HALF + m * 16;
#pragma unroll
                    for (int bj = 0; bj < 2; ++bj) { f32x4 v0 = acc[ai][bj][m][0], v1 = acc[ai][bj][m][1];
#pragma unroll
                        for (int j = 0; j < 4; ++j) { v0[j] = sigmoidf_fast(v0[j]); v1[j] = sigmoidf_fast(v1[j]); }
                        *(u32x4*)(dst + (size_t)row * DM + cb + bj * HALF) = pack8(v0, v1); }
                }
        } else if (pn == 20) {
#pragma unroll
            for (int ai = 0; ai < 2; ++ai)
#pragma unroll
                for (int m = 0; m < 4; ++m) { const int row = row0 + ai * HALF + m * 16;
#pragma unroll
                    for (int bj = 0; bj < 2; ++bj) *(u32x4*)(QI + (size_t)row * 256 + cl + bj * HALF) = pack8(acc[ai][bj][m][0], acc[ai][bj][m][1]); }
        } else {
            const size_t ob = sample ? O_KI_S : O_KI_P;
#pragma unroll
            for (int ai = 0; ai < 2; ++ai)
#pragma unroll
                for (int m = 0; m < 4; ++m) { const int row = row0 + ai * HALF + m * 16; const f32x4 v0 = acc[ai][0][m][0], v1 = acc[ai][0][m][1];
                    if (cl < 64) { *(u32x4*)(KI + (size_t)row * 64 + cl) = pack8(v0, v1);
                        float* o = out + ob + (size_t)(sample ? row - MP : row) * 64 + cl; *(f32x4*)o = v0; *(f32x4*)(o + 4) = v1; }
                    else if (cl == 64) *(f32x4*)(WX + (size_t)row * 4) = v0;
                }
        }
    }
};

template <class Epi, class Sched, bool ALIGN_EPI = false, bool SP2 = false>
__device__ __forceinline__ void gemm_phase(PG8_LAS unsigned char* lds, const Gemm g, const Sched& S, const Epi& E) {
    const int tid = threadIdx.x, wid = __builtin_amdgcn_readfirstlane(tid >> 6), lane = tid & 63, wr = wid >> 2, wc = wid & 3, fr = lane & 15, fq = lane >> 4;
    const int K = g.K, nt = K / BK;
    unsigned voffA[2], voffB[2];
#pragma unroll
    for (int i = 0; i < 2; ++i) { int R, C; stage_rc(tid * 16 + i * 8192, R, C); const int Rb = Epi::PERM ? ((R & ~31) + perm32(R & 31)) : R;
        voffA[i] = (unsigned)(R * K + C) * 2u; voffB[i] = (unsigned)(Rb * K + C) * 2u; }
    const size_t kstep = (size_t)(BK * 2);
    const size_t hstep = (size_t)HALF * K * 2;
    const size_t tstep = 2 * hstep;
    const unsigned ldsw = (unsigned)wid * 1024u;
    const int aoff = lds_byte(wr * 64 + fr, fq * 8), boff = lds_byte(wc * 32 + fr, fq * 8);
#define PG8_SA(b, h) (((b) * 2 + (h)) * HTB)
#define PG8_SB(b, h) ((4 + (b) * 2 + (h)) * HTB)
#define PG8_STAGE(bufoff, gbase, voff) do { _Pragma("unroll") for (int _i = 0; _i < 2; ++_i) \
        __builtin_amdgcn_global_load_lds((const unsigned*)((const char*)(gbase) + (voff)[_i]), (PG8_LAS unsigned*)(lds + (bufoff) + ldsw + _i * 8192), 16, 0, 0); } while (0)
#define PG8_LDA(dst, b, h) do { _Pragma("unroll") for (int m = 0; m < 4; ++m) _Pragma("unroll") for (int k = 0; k < 2; ++k) dst[m][k] = *(const PG8_LAS bf16x8*)(lds + PG8_SA(b, h) + aoff + m * 2048 + k * 1024); } while (0)
#define PG8_LDB(dst, b, h) do { _Pragma("unroll") for (int n = 0; n < 2; ++n) _Pragma("unroll") for (int k = 0; k < 2; ++k) dst[n][k] = *(const PG8_LAS bf16x8*)(lds + PG8_SB(b, h) + boff + n * 2048 + k * 1024); } while (0)
#define PG8_MMA(ai, bj, At, Bt) do { __builtin_amdgcn_s_setprio(1); _Pragma("unroll") for (int m = 0; m < 4; ++m) _Pragma("unroll") for (int n = 0; n < 2; ++n) _Pragma("unroll") for (int k = 0; k < 2; ++k) \
        acc[ai][bj][m][n] = __builtin_amdgcn_mfma_f32_16x16x32_bf16(Bt[n][k], At[m][k], acc[ai][bj][m][n], 0, 0, 0); __builtin_amdgcn_s_setprio(0); } while (0)
#define PG8_WAIT_V(n) asm volatile("s_waitcnt vmcnt(" #n ")" ::: "memory")
#define PG8_WAIT_L(n) asm volatile("s_waitcnt lgkmcnt(" #n ")" ::: "memory")
#define PG8_BAR __builtin_amdgcn_s_barrier()
#define PG8_SCHED __builtin_amdgcn_sched_barrier(0)
    Unit cur, nxt; int ui = 0;
    if (!S.next(0, cur)) return;
    f32x4 acc[2][2][4][2];
#pragma unroll
    for (int a = 0; a < 2; ++a)
#pragma unroll
        for (int b = 0; b < 2; ++b)
#pragma unroll
            for (int m = 0; m < 4; ++m)
#pragma unroll
                for (int n = 0; n < 2; ++n) acc[a][b][m][n] = (f32x4){0.f, 0.f, 0.f, 0.f};
    bf16x8 At[4][2], B0[2][2], B1[2][2];
    const char* cA = (const char*)g.A + (size_t)cur.pm * tstep; const char* cB = (const char*)g.Bt + (size_t)cur.pn * tstep;
    S.a_ready(cur);
    if constexpr (SP2) {
        PG8_STAGE(PG8_SB(0, 0), cB, voffB); PG8_STAGE(PG8_SB(0, 1), cB + hstep, voffB); PG8_STAGE(PG8_SA(0, 0), cA, voffA); PG8_STAGE(PG8_SA(0, 1), cA + hstep, voffA);
        if (wr == 1) PG8_BAR;
        PG8_WAIT_V(2); PG8_BAR;
        PG8_STAGE(PG8_SB(1, 0), cB + kstep, voffB); PG8_STAGE(PG8_SA(1, 0), cA + kstep, voffA); PG8_STAGE(PG8_SB(1, 1), cB + hstep + kstep, voffB);
        PG8_WAIT_V(6); PG8_BAR;
    } else {
        PG8_STAGE(PG8_SB(0, 0), cB, voffB); PG8_STAGE(PG8_SA(0, 0), cA, voffA); PG8_STAGE(PG8_SB(0, 1), cB + hstep, voffB); PG8_STAGE(PG8_SA(0, 1), cA + hstep, voffA);
        if (wr == 1) PG8_BAR;
        PG8_WAIT_V(4); PG8_BAR;
        PG8_STAGE(PG8_SB(1, 0), cB + kstep, voffB); PG8_STAGE(PG8_SA(1, 0), cA + kstep, voffA); PG8_STAGE(PG8_SB(1, 1), cB + hstep + kstep, voffB);
        PG8_WAIT_V(6); PG8_BAR;
    }
    for (;;) {
        const bool has_next = S.next(ui + 1, nxt);
        const char* nA = has_next ? (const char*)g.A + (size_t)nxt.pm * tstep : cA; const char* nB = has_next ? (const char*)g.Bt + (size_t)nxt.pn * tstep : cB;
        for (int t = 0; t < nt; t += 2) {
            const bool last = (t == nt - 2);
            const char* a1 = cA + (size_t)(t + 1) * kstep;
            const char* a2 = last ? nA : cA + (size_t)(t + 2) * kstep; const char* b2 = last ? nB : cB + (size_t)(t + 2) * kstep;
            const char* a3 = a2 + kstep; const char* b3 = b2 + kstep;
            if (last && has_next) S.a_ready(nxt);
            if constexpr (SP2) {
            PG8_LDB(B0, 0, 0); PG8_LDB(B1, 0, 1); PG8_SCHED; PG8_LDA(At, 0, 0); PG8_STAGE(PG8_SA(1, 1), a1 + hstep, voffA);
            PG8_WAIT_V(8); PG8_WAIT_L(0); PG8_BAR; PG8_MMA(0, 0, At, B0); PG8_MMA(0, 1, At, B1); PG8_BAR; PG8_SCHED;
            PG8_LDA(At, 0, 1); PG8_STAGE(PG8_SB(0, 0), b2, voffB); PG8_STAGE(PG8_SB(0, 1), b2 + hstep, voffB); PG8_STAGE(PG8_SA(0, 0), a2, voffA);
            PG8_WAIT_V(8); PG8_WAIT_L(0); PG8_BAR; PG8_MMA(1, 0, At, B0); PG8_MMA(1, 1, At, B1); PG8_BAR; PG8_SCHED;
            PG8_LDB(B0, 1, 0); PG8_LDB(B1, 1, 1); PG8_SCHED; PG8_LDA(At, 1, 0); PG8_STAGE(PG8_SA(0, 1), a2 + hstep, voffA);
            PG8_WAIT_V(8); PG8_WAIT_L(0); PG8_BAR; PG8_MMA(0, 0, At, B0); PG8_MMA(0, 1, At, B1); PG8_BAR; PG8_SCHED;
            PG8_LDA(At, 1, 1); PG8_STAGE(PG8_SB(1, 0), b3, voffB); PG8_STAGE(PG8_SB(1, 1), b3 + hstep, voffB); PG8_STAGE(PG8_SA(1, 0), a3, voffA);
            PG8_WAIT_V(8); PG8_WAIT_L(0); PG8_BAR; PG8_MMA(1, 0, At, B0); PG8_MMA(1, 1, At, B1); PG8_BAR; PG8_SCHED;
            } else {
            PG8_LDB(B0, 0, 0); PG8_SCHED; PG8_LDA(At, 0, 0); PG8_STAGE(PG8_SA(1, 1), a1 + hstep, voffA);
            PG8_WAIT_L(8); PG8_BAR; PG8_WAIT_L(0); PG8_MMA(0, 0, At, B0); PG8_BAR; PG8_SCHED;
            PG8_LDB(B1, 0, 1); PG8_STAGE(PG8_SB(0, 0), b2, voffB);
            PG8_BAR; PG8_WAIT_L(0); PG8_MMA(0, 1, At, B1); PG8_BAR;
            PG8_LDA(At, 0, 1); PG8_STAGE(PG8_SA(0, 0), a2, voffA);
            PG8_BAR; PG8_WAIT_L(0); PG8_MMA(1, 0, At, B0); PG8_BAR; PG8_SCHED;
            PG8_STAGE(PG8_SB(0, 1), b2 + hstep, voffB);
            PG8_WAIT_V(6); PG8_BAR; PG8_MMA(1, 1, At, B1); PG8_BAR;
            PG8_LDB(B0, 1, 0); PG8_SCHED; PG8_LDA(At, 1, 0); PG8_STAGE(PG8_SA(0, 1), a2 + hstep, voffA);
            PG8_WAIT_L(8); PG8_BAR; PG8_WAIT_L(0); PG8_MMA(0, 0, At, B0); PG8_BAR; PG8_SCHED;
            PG8_LDB(B1, 1, 1); PG8_STAGE(PG8_SB(1, 0), b3, voffB);
            PG8_BAR; PG8_WAIT_L(0); PG8_MMA(0, 1, At, B1); PG8_BAR;
            PG8_LDA(At, 1, 1); PG8_STAGE(PG8_SA(1, 0), a3, voffA);
            PG8_BAR; PG8_WAIT_L(0); PG8_MMA(1, 0, At, B0); PG8_BAR; PG8_SCHED;
            PG8_STAGE(PG8_SB(1, 1), b3 + hstep, voffB);
            PG8_WAIT_V(6); PG8_BAR; PG8_MMA(1, 1, At, B1); PG8_BAR;
            }
        }
        if constexpr (ALIGN_EPI) { if (wr == 0) PG8_BAR; }
        if constexpr (!Epi::AFTER_DRAIN) { E(acc, cur, wr, wc, fr, fq); S.done(cur); }
        if (!has_next) break;
#pragma unroll
        for (int a = 0; a < 2; ++a)
#pragma unroll
            for (int b = 0; b < 2; ++b)
#pragma unroll
                for (int m = 0; m < 4; ++m)
#pragma unroll
                    for (int n = 0; n < 2; ++n) acc[a][b][m][n] = (f32x4){0.f, 0.f, 0.f, 0.f};
        cur = nxt; cA = nA; cB = nB; ++ui;
        if constexpr (ALIGN_EPI) { if (wr == 1) PG8_BAR; }
    }
    PG8_WAIT_V(0);
    if constexpr (!ALIGN_EPI) { if (wr == 0) PG8_BAR; }
    PG8_BAR;
    if constexpr (Epi::AFTER_DRAIN) { E.fused(acc, cur, wr, wc, fr, fq, lds, wid, lane); S.done(cur); }
#undef PG8_SA
#undef PG8_SB
#undef PG8_STAGE
#undef PG8_LDA
#undef PG8_LDB
#undef PG8_MMA
#undef PG8_WAIT_V
#undef PG8_WAIT_L
#undef PG8_BAR
#undef PG8_SCHED
}
}
#define GAS __attribute__((address_space(1)))
#define LAS __attribute__((address_space(3)))
typedef unsigned short bf16;
typedef unsigned v4u __attribute__((ext_vector_type(4)));
typedef float f32x4 __attribute__((ext_vector_type(4)));
typedef short bf16x8 __attribute__((ext_vector_type(8)));
typedef GAS unsigned gu32;
typedef GAS unsigned long long gu64;
#define RLX_AGENT __ATOMIC_RELAXED, __HIP_MEMORY_SCOPE_AGENT
#define LDS_WAIT() asm volatile("s_waitcnt lgkmcnt(0)" ::: "memory")
#define VM_WAIT() asm volatile("s_waitcnt vmcnt(0)" ::: "memory")
__device__ __forceinline__ unsigned long long rt() { return __builtin_amdgcn_s_memrealtime(); }
__device__ __forceinline__ unsigned f2bf(float f) { unsigned u = __builtin_bit_cast(unsigned, f); return (u + 0x7fffu + ((u >> 16) & 1u)) >> 16; }
__device__ __forceinline__ unsigned pk2(float lo, float hi) { return f2bf(lo) | (f2bf(hi) << 16); }

#define XB_TMO      128
#define XB_XCNT(j)  (256  + 64 * (j))
#define XB_XSUB(j)  (1280 + 64 * (j))
#define XB_XGEN(j)  (2304 + 64 * (j))
#define XB_TOP      3328
#define XB_TOPGEN   3392
#define XCD_BAR_WORDS 3456
#define XB_SPIN_CAP (1u << 18)

__device__ __forceinline__ unsigned xb_ld(unsigned* p)              { return __hip_atomic_load(p, __ATOMIC_RELAXED, __HIP_MEMORY_SCOPE_AGENT); }
__device__ __forceinline__ unsigned xb_add(unsigned* p, unsigned v) { return __hip_atomic_fetch_add(p, v, __ATOMIC_RELAXED, __HIP_MEMORY_SCOPE_AGENT); }
__device__ __forceinline__ unsigned xb_xcc_id() { return (unsigned)__builtin_amdgcn_s_getreg((3 << 11) | 20) & 0xFu; }
#define XB_SPIN(cond, bar) do { unsigned _sp = 0; while (cond) { __builtin_amdgcn_s_sleep(1); \
    if ((++_sp & 255u) == 0u) { if (xb_ld(&(bar)[XB_TMO])) break; if (_sp > XB_SPIN_CAP) { atomicAdd(&(bar)[XB_TMO], 1u); break; } } } } while (0)

struct XcdBarrier {
    unsigned* bar; unsigned x;
    volatile LAS unsigned* st;
};

__device__ __forceinline__ XcdBarrier xcd_barrier_post(unsigned* bar, volatile LAS unsigned* st) {
    XcdBarrier b; b.bar = bar; b.x = xb_xcc_id(); b.st = st;
    if (threadIdx.x == 0) (void)xb_add(&bar[XB_XCNT(b.x)], 1u);
    return b;
}
__device__ __forceinline__ void xcd_barrier_complete(unsigned* bar, unsigned x, unsigned& nloc, unsigned& nx) {
    const unsigned G = gridDim.x * gridDim.y * gridDim.z;
    unsigned sum, cnt, mine, sp = 0u;
    for (;;) {
        sum = 0u; cnt = 0u; mine = 0u;
#pragma unroll
        for (unsigned j = 0; j < 16; ++j) { const unsigned c = xb_ld(&bar[XB_XCNT(j)]); sum += c; cnt += (c > 0u) ? 1u : 0u; mine = (j == x) ? c : mine; }
        if (sum == G) break;
        __builtin_amdgcn_s_sleep(1);
        if ((++sp & 255u) == 0u) { if (xb_ld(&bar[XB_TMO])) break; if (sp > XB_SPIN_CAP) { atomicAdd(&bar[XB_TMO], 1u); break; } }
    }
    nloc = mine > 0u ? mine : 1u; nx = cnt > 0u ? cnt : 1u;
}

__device__ __forceinline__ void xcd_barrier(const XcdBarrier& b) {
    asm volatile("s_waitcnt vmcnt(0)" ::: "memory");
    __syncthreads();
    if (threadIdx.x == 0) {
        unsigned* bar = b.bar;
        __builtin_amdgcn_s_waitcnt(0);
        unsigned nloc = b.st[0], nx = b.st[1];
        if (nloc == 0u) { xcd_barrier_complete(bar, b.x, nloc, nx); b.st[0] = nloc; b.st[1] = nx; }
        const unsigned old = xb_add(&bar[XB_XSUB(b.x)], 1u);
        const unsigned gen = old / nloc;
        if (old + 1u == (gen + 1u) * nloc) {
            __builtin_amdgcn_fence(__ATOMIC_RELEASE, "agent");
            asm volatile("s_waitcnt vmcnt(0)" ::: "memory");
            const unsigned og = xb_add(&bar[XB_TOP], 1u);
            const unsigned tg = og / nx;
            if (og + 1u == (tg + 1u) * nx) xb_add(&bar[XB_TOPGEN], 1u);
            else XB_SPIN(xb_ld(&bar[XB_TOPGEN]) == tg, bar);
            __builtin_amdgcn_fence(__ATOMIC_ACQUIRE, "agent");
            xb_add(&bar[XB_XGEN(b.x)], 1u);
            asm volatile("s_waitcnt vmcnt(0)" ::: "memory");
        } else {
            XB_SPIN(xb_ld(&bar[XB_XGEN(b.x)]) == gen, bar);
            __builtin_amdgcn_fence(__ATOMIC_ACQUIRE, "agent");
            asm volatile("s_waitcnt vmcnt(0)" ::: "memory");
        }
    }
    __syncthreads();
}

constexpr int NWAVES = 8;
constexpr int N_LAUNCHES = MK_N_LAUNCHES;
constexpr int N_PHASES = 13;
typedef float f32x16 __attribute__((ext_vector_type(16)));
typedef short s16x4 __attribute__((ext_vector_type(4)));
typedef unsigned long long u64;

constexpr size_t MiB = 1u << 20;
constexpr size_t WS_CTL = 0, CTL_ZERO_BYTES = 65536;
constexpr int CW_BAR = 4096;
constexpr size_t WS_W1T = 2 * MiB;
constexpr size_t WS_W1O = 13 * MiB;
constexpr size_t WS_WIN = 19 * MiB;
constexpr size_t WS_WBA = 30 * MiB, WS_WBB = 31 * MiB;
constexpr size_t WS_WOUT = 32 * MiB;
constexpr size_t WS_W2T = 34 * MiB, WS_W2O = 45 * MiB;
constexpr size_t WS_CKA = 51 * MiB, WS_CVA = 59 * MiB;
constexpr size_t WS_CKI = 67 * MiB;
constexpr size_t WS_CKB = 68 * MiB, WS_CVB = 72 * MiB;
constexpr size_t WS_WX = 76 * MiB;
constexpr size_t WS_MASK = 77 * MiB;
constexpr size_t WS_XB = 94 * MiB;
constexpr size_t WS_BIG = 159 * MiB;
constexpr size_t SZ_512 = (size_t)MT * WA * 2;
constexpr size_t WS_QA = WS_BIG, WS_KA = WS_QA + SZ_512, WS_VA = WS_KA + SZ_512, WS_QB = WS_VA + SZ_512, WS_KB = WS_QB + SZ_512, WS_VB = WS_KB + SZ_512;
constexpr size_t WS_GA = WS_VB + SZ_512, WS_GB = WS_GA + (size_t)MT * DM * 2;
constexpr size_t WS_QI = WS_GB + (size_t)MT * DM * 2, WS_KI = WS_QI + (size_t)MT * 256 * 2, WS_END = WS_KI + (size_t)MT * 64 * 2;
static_assert(WS_END <= 512 * MiB, "workspace map");
static_assert(WS_BIG + (size_t)MT * DFF * 2 <= WS_GA, "FFN hidden must not reach the gate/mix region");
constexpr int MASK_TILES_P = NB_P * (128 * 129 / 2);
constexpr int MASK_TILES = MASK_TILES_P + NB_S * 17;
static_assert(WS_MASK + (size_t)MASK_TILES * 512 <= WS_XB, "mask region");

constexpr int LDS_BYTES = 163840;
constexpr int MISC_OFF = 163840 - 256;

struct Args {
    const float* in[23]; float* out; unsigned char* ws; int ph_lo, ph_hi, li, pad;
};

__device__ __forceinline__ float wave_sum(float v) {
#pragma unroll
    for (int o = 1; o < 64; o <<= 1) v += __shfl_xor(v, o);
    return v;
}
__device__ __forceinline__ void tr_item(const float* W, int K, int Nsrc, bf16* WT, int drow0, int scol0, int nvalid, LAS float* scr, int kb, int lane) {
    const int k0 = 64 * kb, j = lane & 31;
#pragma unroll 8
    for (int i = 0; i < 32; ++i) { const int kk = 2 * i + (lane >> 5); scr[kk * 33 + j] = (j < nvalid) ? W[(size_t)(k0 + kk) * Nsrc + scol0 + j] : 0.f; }
    LDS_WAIT(); asm volatile("" ::: "memory");
    const int c = lane & 7;
#pragma unroll
    for (int jj = 0; jj < 4; ++jj) { const int n = (lane >> 3) + 8 * jj; const LAS float* s = scr + (8 * c) * 33 + n;
        v4u o; o.x = pk2(s[0 * 33], s[1 * 33]); o.y = pk2(s[2 * 33], s[3 * 33]); o.z = pk2(s[4 * 33], s[5 * 33]); o.w = pk2(s[6 * 33], s[7 * 33]);
        *(GAS v4u*)(WT + (size_t)(drow0 + n) * K + k0 + 8 * c) = o; }
    LDS_WAIT(); asm volatile("" ::: "memory");
}
__device__ __forceinline__ int up_src(int g) { const int pn = g >> 3, j0 = (g & 7) * 32; return (j0 < 128) ? 128 * pn + j0 : DFF + 128 * pn + (j0 - 128); }
__device__ __forceinline__ void win_src(int g, int& s0, int& nv) {
    const int d0 = 32 * g; nv = 32;
    if (d0 < 1536) s0 = d0;
    else if (d0 < 3072) s0 = 1860 + (d0 - 1536);
    else if (d0 < 5120) s0 = 3396 + (d0 - 3072);
    else if (d0 < 5376) s0 = 1536 + (d0 - 5120);
    else if (d0 < 5440) s0 = 1792 + (d0 - 5376);
    else if (d0 == 5440) { s0 = 1856; nv = 4; }
    else { s0 = 0; nv = 0; }
}
__device__ __forceinline__ void cvt_flat(const float* src, bf16* dst, size_t n8, size_t gt, size_t ngt) {
    for (size_t i = gt; i < n8; i += ngt) { const f32x4 a = *(const GAS f32x4*)(src + i * 8), b = *(const GAS f32x4*)(src + i * 8 + 4);
        v4u o; o.x = pk2(a.x, a.y); o.y = pk2(a.z, a.w); o.z = pk2(b.x, b.y); o.w = pk2(b.z, b.w); *(GAS v4u*)(dst + i * 8) = o; }
}

__device__ __forceinline__ void p0_prologue(const Args& A, LAS unsigned char* lds, int vcu, int G, int wave, int lane, int tid) {
    unsigned char* ws = A.ws;
    LAS float* scr = (LAS float*)(lds + wave * 16384);
    const int gw = vcu * NWAVES + wave, NGW = G * NWAVES;
    const float *ffn1_wi = A.in[10], *ffn1_wo = A.in[11], *w_in = A.in[14], *wba = A.in[16], *wbb = A.in[17], *wout = A.in[18], *ffn2_wi = A.in[21], *ffn2_wo = A.in[22];
    constexpr int I_UP = 16 * 176, I_DN = 44 * 32, I_IN = 16 * 176, I_BR = 8 * 32, I_OUT = 16 * 32;
    constexpr int NITEMS = 2 * I_UP + 2 * I_DN + I_IN + 2 * I_BR + I_OUT;
    for (int it = gw; it < NITEMS; it += NGW) {
        int r = it;
        if (r < I_UP) { const int kb = r / 176, g = r % 176; tr_item(ffn1_wi, DM, NUP, (bf16*)(ws + WS_W1T), 32 * g, up_src(g), 32, scr, kb, lane); continue; } r -= I_UP;
        if (r < I_UP) { const int kb = r / 176, g = r % 176; tr_item(ffn2_wi, DM, NUP, (bf16*)(ws + WS_W2T), 32 * g, up_src(g), 32, scr, kb, lane); continue; } r -= I_UP;
        if (r < I_DN) { const int kb = r / 32, g = r % 32; tr_item(ffn1_wo, DFF, DM, (bf16*)(ws + WS_W1O), 32 * g, 32 * g, 32, scr, kb, lane); continue; } r -= I_DN;
        if (r < I_DN) { const int kb = r / 32, g = r % 32; tr_item(ffn2_wo, DFF, DM, (bf16*)(ws + WS_W2O), 32 * g, 32 * g, 32, scr, kb, lane); continue; } r -= I_DN;
        if (r < I_IN) { const int kb = r / 176, g = r % 176; int s0, nv; win_src(g, s0, nv); tr_item(w_in, DM, NIN, (bf16*)(ws + WS_WIN), 32 * g, s0, nv, scr, kb, lane); continue; } r -= I_IN;
        if (r < I_BR) { const int kb = r / 32, g = r % 32; tr_item(wba, WA, DM, (bf16*)(ws + WS_WBA), 32 * g, 32 * g, 32, scr, kb, lane); continue; } r -= I_BR;
        if (r < I_BR) { const int kb = r / 32, g = r % 32; tr_item(wbb, WA, DM, (bf16*)(ws + WS_WBB), 32 * g, 32 * g, 32, scr, kb, lane); continue; } r -= I_BR;
        { const int kb = r / 32, g = r % 32; tr_item(wout, DM, DM, (bf16*)(ws + WS_WOUT), 32 * g, 32 * g, 32, scr, kb, lane); }
    }
#if defined(DBG_PREFILL)
    { const size_t gt_ = (size_t)(vcu * NWAVES + wave) * 64 + lane, ngt_ = (size_t)G * NWAVES * 64; GAS v4u* gz = (GAS v4u*)(ws + WS_GA); for (size_t i = gt_; i < (size_t)MT * DM * 2 * 2 / 16; i += ngt_) gz[i] = (v4u){0x3F803F80u, 0x3F803F80u, 0x3F803F80u, 0x3F803F80u}; }
#endif
    const size_t gt = (size_t)(vcu * NWAVES + wave) * 64 + lane, ngt = (size_t)G * NWAVES * 64;
    cvt_flat(A.in[0], (bf16*)(ws + WS_XB), (size_t)MP * DM / 8, gt, ngt);
    cvt_flat(A.in[1], (bf16*)(ws + WS_XB) + (size_t)MP * DM, (size_t)MS * DM / 8, gt, ngt);
    cvt_flat(A.in[2], (bf16*)(ws + WS_CKA), (size_t)NB_S * PAST * WA / 8, gt, ngt);
    cvt_flat(A.in[3], (bf16*)(ws + WS_CVA), (size_t)NB_S * PAST * WA / 8, gt, ngt);
    cvt_flat(A.in[4], (bf16*)(ws + WS_CKI), (size_t)NB_S * PAST * 64 / 8, gt, ngt);
    cvt_flat(A.in[5], (bf16*)(ws + WS_CKB), (size_t)NB_S * BANDC * WA / 8, gt, ngt);
    cvt_flat(A.in[6], (bf16*)(ws + WS_CVB), (size_t)NB_S * BANDC * WA / 8, gt, ngt);
    { constexpr size_t PER = (size_t)(BANDC - DSEQ) * WA / 4;
      for (size_t i = gt; i < 2 * NB_S * PER; i += ngt) { const int which = (int)(i / (NB_S * PER)); const size_t r = i % (NB_S * PER); const int b = (int)(r / PER); const size_t e = (r % PER) * 4;
          const float* src = A.in[which ? 6 : 5] + ((size_t)b * BANDC + DSEQ) * WA + e; float* dst = A.out + (which ? O_VB_S : O_KB_S) + (size_t)b * BANDC * WA + e;
          *(GAS f32x4*)dst = *(const GAS f32x4*)src; } }
}

template <bool F32OUT> __device__ __forceinline__ void ln_pass(const float* src, const float* g, const float* b, bf16* dstb, float* dstf, int gw, int NGW, int lane) {
    f32x4 gv[4], bv[4];
#pragma unroll
    for (int j = 0; j < 4; ++j) { gv[j] = *((const GAS f32x4*)g + lane + 64 * j); bv[j] = *((const GAS f32x4*)b + lane + 64 * j); }
    for (int m = gw; m < MT; m += NGW) {
        const GAS f32x4* xr = (const GAS f32x4*)(src + (size_t)m * DM) + lane;
        f32x4 v[4]; float s = 0.f;
#pragma unroll
        for (int j = 0; j < 4; ++j) { v[j] = xr[64 * j]; s += (v[j].x + v[j].y) + (v[j].z + v[j].w); }
        const float mean = wave_sum(s) * (1.f / DM); float s2 = 0.f;
#pragma unroll
        for (int j = 0; j < 4; ++j) { v[j] = v[j] - mean; s2 += (v[j].x * v[j].x + v[j].y * v[j].y) + (v[j].z * v[j].z + v[j].w * v[j].w); }
        const float rstd = 1.f / sqrtf(wave_sum(s2) * (1.f / DM) + LN_EPS);
#pragma unroll
        for (int j = 0; j < 4; ++j) { v[j] = v[j] * rstd * gv[j] + bv[j]; }
        if (F32OUT) { GAS f32x4* o = (GAS f32x4*)(dstf + (size_t)m * DM) + lane;
#pragma unroll
            for (int j = 0; j < 4; ++j) o[64 * j] = v[j];
        } else { GAS unsigned long long* o8 = (GAS unsigned long long*)(dstb + (size_t)m * DM) + lane;
#pragma unroll
            for (int j = 0; j < 4; ++j) o8[64 * j] = (unsigned long long)pk2(v[j].x, v[j].y) | ((unsigned long long)pk2(v[j].z, v[j].w) << 32); }
    }
}

namespace idxp {
constexpr int NBIN = 1024, CAP = 128, NSEL = 256;
constexpr int L_HIST = 0;
constexpr int L_LMASK = 65536;
constexpr int L_PSUM = 131072;
constexpr int L_BSTAR = L_PSUM + 2048;
constexpr int L_CABOVE = L_BSTAR + 256;
constexpr int L_NCAND = L_CABOVE + 256;
struct IUnit { int kind, b, c; };

__device__ __forceinline__ float score4(const f32x4 (&d)[4], int reg, const float (&w)[4]) {
    float r = w[0] * __builtin_fmaxf(d[0][reg], 0.f);
    r = __builtin_fmaf(w[1], __builtin_fmaxf(d[1][reg], 0.f), r);
    r = __builtin_fmaf(w[2], __builtin_fmaxf(d[2][reg], 0.f), r);
    r = __builtin_fmaf(w[3], __builtin_fmaxf(d[3][reg], 0.f), r);
    return r;
}
__device__ __forceinline__ int sbin(float s, float lo, float inv) { const float x = (s - lo) * inv; int bi = (int)x; bi = bi < 0 ? 0 : bi; return bi > NBIN - 1 ? NBIN - 1 : bi; }
__device__ __forceinline__ unsigned skey(float s) { unsigned b = __float_as_uint(s); if ((b << 1) == 0u) b = 0u; return b ^ ((b >> 31) ? 0xFFFFFFFFu : 0x80000000u); }
__device__ __forceinline__ const bf16* ki_tile(const IUnit& u, int t, const bf16* KI, const bf16* CKI) {
    if (u.kind == 0) return KI + (size_t)(u.b * SEQ + 64 * t) * 64;
    return (t < 16) ? CKI + (size_t)(u.b * PAST + 64 * t) * 64 : KI + (size_t)(MP + u.b * DSEQ) * 64;
}
__device__ __forceinline__ int mask_tile_base(int kind, int b, int c) { return kind == 0 ? b * (128 * 129 / 2) + c * (c + 1) / 2 : MASK_TILES_P + b * 17; }

template <int MODE> __device__ __forceinline__ void idx_sweep(const IUnit& u, const bf16* KI, const bf16* CKI, const bf16x8 (&Bq)[4][2], const float (&wsc)[4], float lo, float inv, int bstar,
                                                            LAS unsigned char* lds, unsigned* maskw, int wave, int lane) {
    const int qb = wave & 3, kp = wave >> 2, l15 = lane & 15, lg = lane >> 4, qloc = 16 * qb + l15, nt = u.c + 1;
    LAS unsigned* hist = (LAS unsigned*)(lds + L_HIST); LAS u64* cand = (LAS u64*)(lds + L_HIST); LAS unsigned* ncand = (LAS unsigned*)(lds + L_NCAND);
    bf16x8 An[2][2];
    { const bf16* Kt = ki_tile(u, 0, KI, CKI);
#pragma unroll
      for (int kbi = 0; kbi < 2; ++kbi)
#pragma unroll
          for (int ks = 0; ks < 2; ++ks) An[kbi][ks] = *(const GAS bf16x8*)(Kt + (size_t)(32 * kp + 16 * kbi + l15) * 64 + ks * 32 + 8 * lg); }
    for (int t = 0; t < nt; ++t) {
        bf16x8 Ac[2][2];
#pragma unroll
        for (int kbi = 0; kbi < 2; ++kbi)
#pragma unroll
            for (int ks = 0; ks < 2; ++ks) Ac[kbi][ks] = An[kbi][ks];
        if (t + 1 < nt) { const bf16* Kt = ki_tile(u, t + 1, KI, CKI);
#pragma unroll
            for (int kbi = 0; kbi < 2; ++kbi)
#pragma unroll
                for (int ks = 0; ks < 2; ++ks) An[kbi][ks] = *(const GAS bf16x8*)(Kt + (size_t)(32 * kp + 16 * kbi + l15) * 64 + ks * 32 + 8 * lg); }
        unsigned bits32 = 0u;
#pragma unroll
        for (int kbi = 0; kbi < 2; ++kbi) {
            f32x4 d[4];
#pragma unroll
            for (int hh = 0; hh < 4; ++hh) { d[hh] = __builtin_amdgcn_mfma_f32_16x16x32_bf16(Ac[kbi][0], Bq[hh][0], (f32x4){0.f, 0.f, 0.f, 0.f}, 0, 0, 0);
                                             d[hh] = __builtin_amdgcn_mfma_f32_16x16x32_bf16(Ac[kbi][1], Bq[hh][1], d[hh], 0, 0, 0); }
            unsigned nib = 0u;
#pragma unroll
            for (int reg = 0; reg < 4; ++reg) {
                const float s = score4(d, reg, wsc); const int bi = sbin(s, lo, inv);
                if (MODE == 0) { __hip_atomic_fetch_add(hist + qloc * 512 + (bi >> 1), 1u << (16 * (bi & 1)), __ATOMIC_RELAXED, __HIP_MEMORY_SCOPE_WORKGROUP); }
                else { nib |= (bi > bstar ? 1u : 0u) << reg;
                    if (bi == bstar) { const unsigned pos = __hip_atomic_fetch_add(ncand + qloc, 1u, __ATOMIC_RELAXED, __HIP_MEMORY_SCOPE_WORKGROUP);
                        const unsigned kidx = (unsigned)(64 * t + 32 * kp + 16 * kbi + 4 * lg + reg);
                        if (pos < (unsigned)CAP) cand[qloc * CAP + pos] = ((u64)skey(s) << 32) | (u64)(0xFFFFFFFFu - kidx); } }
            }
            if (MODE == 1) { unsigned v = nib << (4 * lg); v |= (unsigned)__shfl_xor((int)v, 16); v |= (unsigned)__shfl_xor((int)v, 32); bits32 |= v << (16 * kbi); }
        }
        if (MODE == 1) { if (lane < 16) ((LAS unsigned*)(lds + L_LMASK))[(t * 64 + qloc) * 2 + kp] = bits32; }
    }
}

__device__ __forceinline__ void idx_unit(const IUnit& u, const bf16* QI, const bf16* KI, const bf16* CKI, const float* WX, unsigned* maskall, LAS unsigned char* lds, int wave, int lane, int tid) {
    const int nt = u.c + 1, L = 64 * nt;
    unsigned* maskw = maskall + (size_t)mask_tile_base(u.kind, u.b, u.c) * 128;
    if (L <= NSEL) {
        for (int i = tid; i < nt * 128; i += NWAVES * 64) maskw[i] = 0xFFFFFFFFu;
        return;
    }
    const int qb = wave & 3, l15 = lane & 15, lg = lane >> 4, qloc = 16 * qb + l15;
    const int m0 = (u.kind == 0) ? u.b * SEQ + 64 * u.c : MP + u.b * DSEQ;
    bf16x8 Bq[4][2]; float wsc[4], nrm2[4];
#pragma unroll
    for (int hh = 0; hh < 4; ++hh) { float a = 0.f;
#pragma unroll
        for (int ks = 0; ks < 2; ++ks) { Bq[hh][ks] = *(const GAS bf16x8*)(QI + (size_t)(m0 + qloc) * 256 + hh * 64 + ks * 32 + 8 * lg);
#pragma unroll
            for (int j = 0; j < 8; ++j) { const float x = __uint_as_float((unsigned)(unsigned short)Bq[hh][ks][j] << 16); a += x * x; } }
        a += __shfl_xor(a, 16); a += __shfl_xor(a, 32); nrm2[hh] = a;
        wsc[hh] = WX[(size_t)(m0 + qloc) * 4 + hh] * 0.0625f; }
    float sig2 = 0.f, mu = 0.f;
#pragma unroll
    for (int hh = 0; hh < 4; ++hh) { sig2 += wsc[hh] * wsc[hh] * nrm2[hh]; mu += wsc[hh] * sqrtf(nrm2[hh]); }
    const float sig = sqrtf(__builtin_fmaxf(sig2, 1e-30f)); mu *= 0.3989423f;
    const float lo = mu - 6.0f * sig, inv = (float)NBIN / (12.0f * sig);
    idx_sweep<0>(u, KI, CKI, Bq, wsc, lo, inv, 0, lds, maskw, wave, lane);
    __syncthreads();
    LAS unsigned* hist = (LAS unsigned*)(lds + L_HIST); LAS unsigned* psum = (LAS unsigned*)(lds + L_PSUM);
    LAS int* bst = (LAS int*)(lds + L_BSTAR); LAS int* cab = (LAS int*)(lds + L_CABOVE); LAS unsigned* ncand = (LAS unsigned*)(lds + L_NCAND);
    { const int q = tid >> 3, part = tid & 7; unsigned s = 0u;
      for (int w = 0; w < 64; ++w) { const unsigned x = hist[q * 512 + 64 * part + w]; s += (x & 0xffffu) + (x >> 16); }
      psum[q * 8 + part] = s; }
    __syncthreads();
    if ((tid & 7) == 0) { const int q = tid >> 3; int cum = 0, P = 7;
        for (; P > 0; --P) { const int s = (int)psum[q * 8 + P]; if (cum + s >= NSEL) break; cum += s; }
        int bstar = 0;
        for (int w = 64 * P + 63; w >= 64 * P; --w) { const unsigned x = hist[q * 512 + w]; const int hi = (int)(x >> 16), lw = (int)(x & 0xffffu);
            if (cum + hi >= NSEL) { bstar = 2 * w + 1; break; } cum += hi;
            if (cum + lw >= NSEL) { bstar = 2 * w; break; } cum += lw; }
        bst[q] = bstar; cab[q] = cum; ncand[q] = 0u; }
    __syncthreads();
    const int bstar = bst[qloc];
    idx_sweep<1>(u, KI, CKI, Bq, wsc, lo, inv, bstar, lds, maskw, wave, lane);
    __syncthreads();
    { const int q = tid >> 3, j = tid & 7; LAS u64* cand = (LAS u64*)(lds + L_HIST) + q * CAP; LAS unsigned* lmask = (LAS unsigned*)(lds + L_LMASK);
      const int n = (int)(ncand[q] < (unsigned)CAP ? ncand[q] : (unsigned)CAP), need = NSEL - cab[q];
      for (int i = j; i < n; i += 8) { const u64 Ci = cand[i]; int r = 0;
          for (int k = 0; k < n; ++k) r += (cand[k] > Ci) ? 1 : 0;
          if (r < need) { const unsigned kidx = 0xFFFFFFFFu - (unsigned)Ci; const int tt = (int)(kidx >> 6), kk = (int)(kidx & 63u);
              __hip_atomic_fetch_or(lmask + (tt * 64 + q) * 2 + (kk >> 5), 1u << (kk & 31), __ATOMIC_RELAXED, __HIP_MEMORY_SCOPE_WORKGROUP); } } }
    __syncthreads();
    { const LAS v4u* src = (const LAS v4u*)(lds + L_LMASK); GAS v4u* dst = (GAS v4u*)maskw; for (int i = tid; i < nt * 32; i += NWAVES * 64) dst[i] = src[i]; }
    __syncthreads();
    { LAS v4u* z = (LAS v4u*)(lds + L_HIST); for (int i = tid; i < 131072 / 16; i += NWAVES * 64) z[i] = (v4u){0u, 0u, 0u, 0u}; }
    __syncthreads();
}

__device__ __forceinline__ void idx_phase(const Args& A, LAS unsigned char* lds, int vcu, int G, int wave, int lane, int tid) {
    unsigned char* ws = A.ws;
    const bf16 *QI = (const bf16*)(ws + WS_QI), *KI = (const bf16*)(ws + WS_KI), *CKI = (const bf16*)(ws + WS_CKI); const float* WX = (const float*)(ws + WS_WX);
    unsigned* maskall = (unsigned*)(ws + WS_MASK);
    { LAS v4u* z = (LAS v4u*)(lds + L_HIST); for (int i = tid; i < 131072 / 16; i += NWAVES * 64) z[i] = (v4u){0u, 0u, 0u, 0u}; }
    __syncthreads();
    for (int j = vcu; j < 256; j += G) { const int b = j >> 6, i = j & 63;
        IUnit u{0, b, 127 - i}; idx_unit(u, QI, KI, CKI, WX, maskall, lds, wave, lane, tid);
        IUnit v{0, b, i}; idx_unit(v, QI, KI, CKI, WX, maskall, lds, wave, lane, tid); }
    for (int j = vcu; j < NB_S; j += G) { IUnit u{1, j, 16}; idx_unit(u, QI, KI, CKI, WX, maskall, lds, wave, lane, tid); }
}
}

namespace attp {
constexpr int L_WAVE = 16384;
constexpr int L_SCR = 131072;
constexpr int L_LUT = L_SCR + 4096;
struct AUnit { int kind, b, c; };
struct Ptrs { const bf16 *QA, *KA, *VA, *QB, *KB, *VB, *CKA, *CVA, *CKB, *CVB; bf16 *OA, *OB; const u64* mask; };
__device__ __forceinline__ int crow(int r, int hi) { return (r & 3) + 8 * (r >> 2) + 4 * hi; }

__device__ __forceinline__ void build_lut(const float* t5, const float* relb, LAS unsigned char* lds, int tid) {
    LAS float* lut = (LAS float*)(lds + L_LUT);
    for (int i = tid; i < 2 * 8 * 256; i += NWAVES * 64) { const int kind = i >> 11, h = (i >> 8) & 7, rel = (i & 255) - 192; float v;
        if (kind == 0) { const int n = rel < 0 ? -rel : rel; int bk;
            if (n < 8) bk = n; else { const int lg = 31 - __builtin_clz((unsigned)(n * n)); bk = 8 + lg - 6; bk = bk > 15 ? 15 : bk; }
            if (rel > 0) bk += 16;
            v = t5[h * 32 + bk] - t5[h * 32 + 15];
        } else { int ri = rel < -128 ? -128 : rel; ri = ri > 63 ? 63 : ri; v = relb[h * 192 + ri + 128] - relb[h * 192]; }
        lut[i] = v * LOG2E; }
}

__device__ __forceinline__ void attn_unit(const AUnit& u, const Ptrs& P, LAS unsigned char* lds, int wave, int lane_in) {
    const bool HAS_MASK = (u.kind < 2);
    const int h = wave;
    LAS unsigned char* kreg = lds + wave * L_WAVE; LAS unsigned char* vreg = kreg + 8192;
    LAS float* wsf = (LAS float*)(lds + L_SCR + wave * 512);
    const LAS float* lut = (const LAS float*)(lds + L_LUT) + ((u.kind >= 2 ? 8 : 0) + h) * 256;
    const int qrow0 = (u.kind & 1) ? MP + u.b * DSEQ : u.b * SEQ + 64 * u.c;
    const int qc = (u.kind & 1) ? 16 : u.c;
    const int t0 = (u.kind == 0 || u.kind == 1) ? 0 : ((u.kind == 2) ? (u.c > 8 ? u.c - 8 : 0) : 8), t1 = qc;
    const bf16* Qp = ((u.kind < 2) ? P.QA : P.QB) + (size_t)qrow0 * WA + h * 64;
    bf16* Op = ((u.kind < 2) ? P.OA : P.OB) + (size_t)qrow0 * WA + h * 64;
    const u64* mk_base = HAS_MASK ? P.mask + (size_t)idxp::mask_tile_base(u.kind, u.b, u.c) * 64 : nullptr;
    bf16x8 qr[2][4];
    { const int r32 = lane_in & 31, hi = lane_in >> 5;
#pragma unroll
    for (int qb = 0; qb < 2; ++qb)
#pragma unroll
        for (int d0 = 0; d0 < 4; ++d0) qr[qb][d0] = *(const GAS bf16x8*)(Qp + (size_t)(32 * qb + r32) * WA + d0 * 16 + hi * 8); }
    f32x16 o[2][2];
#pragma unroll
    for (int a = 0; a < 2; ++a)
#pragma unroll
        for (int b = 0; b < 2; ++b)
#pragma unroll
            for (int r = 0; r < 16; ++r) o[a][b][r] = 0.f;
    float mrun[2] = {-1e30f, -1e30f}, lrun[2] = {0.f, 0.f};
    const float NEG = -__builtin_inff();
    for (int t = t0; t <= t1; ++t) {
        int lane = lane_in; asm volatile("" : "+v"(lane));
        const int r32 = lane & 31, hi = lane >> 5;
        const bf16 *Kt, *Vt;
        if (u.kind == 0) { Kt = P.KA + (size_t)(u.b * SEQ + 64 * t) * WA; Vt = P.VA + (size_t)(u.b * SEQ + 64 * t) * WA; }
        else if (u.kind == 1) { if (t < 16) { Kt = P.CKA + (size_t)(u.b * PAST + 64 * t) * WA; Vt = P.CVA + (size_t)(u.b * PAST + 64 * t) * WA; } else { Kt = P.KA + (size_t)(MP + u.b * DSEQ) * WA; Vt = P.VA + (size_t)(MP + u.b * DSEQ) * WA; } }
        else if (u.kind == 2) { Kt = P.KB + (size_t)(u.b * SEQ + 64 * t) * WA; Vt = P.VB + (size_t)(u.b * SEQ + 64 * t) * WA; }
        else { if (t < 16) { Kt = P.CKB + (size_t)(u.b * BANDC + 64 * (t - 8)) * WA; Vt = P.CVB + (size_t)(u.b * BANDC + 64 * (t - 8)) * WA; } else { Kt = P.KB + (size_t)(MP + u.b * DSEQ) * WA; Vt = P.VB + (size_t)(MP + u.b * DSEQ) * WA; } }
        Kt += h * 64; Vt += h * 64;
        LDS_WAIT(); asm volatile("" ::: "memory");
#pragma unroll
        for (int c8 = 0; c8 < 8; ++c8) __builtin_amdgcn_global_load_lds((const unsigned*)(Kt + (size_t)lane * WA + c8 * 8), (LAS unsigned*)(kreg + c8 * 1024), 16, 0, 0);
#pragma unroll
        for (int p = 0; p < 8; ++p) __builtin_amdgcn_global_load_lds((const unsigned*)(Vt + (size_t)(16 * (p & 3) + (lane >> 2)) * WA + (p >> 2) * 32 + (lane & 3) * 8), (LAS unsigned*)(vreg + p * 1024), 16, 0, 0);
        u64 mk[2] = {~0ull, ~0ull};
        if (HAS_MASK) { mk[0] = mk_base[(size_t)(t - t0) * 64 + r32]; mk[1] = mk_base[(size_t)(t - t0) * 64 + 32 + r32]; }
        VM_WAIT(); asm volatile("" ::: "memory");
        const bool near = (t >= qc - 2);
        const LAS unsigned char* vb = vreg + ((lane >> 4) & 1) * 32 + (lane & 3) * 8 + (4 * hi + ((lane & 15) >> 2)) * 64;
#pragma unroll
        for (int qb = 0; qb < 2; ++qb) {
            __builtin_amdgcn_sched_barrier(0);
            f32x16 p0, p1;
#pragma unroll
            for (int r = 0; r < 16; ++r) { p0[r] = 0.f; p1[r] = 0.f; }
#pragma unroll
            for (int d0 = 0; d0 < 4; ++d0) { const bf16x8 b0 = *(const LAS bf16x8*)(kreg + hi * 1024 + r32 * 16 + d0 * 2048), b1 = *(const LAS bf16x8*)(kreg + hi * 1024 + r32 * 16 + d0 * 2048 + 512);
                p0 = __builtin_amdgcn_mfma_f32_32x32x16_bf16(b0, qr[qb][d0], p0, 0, 0, 0); p1 = __builtin_amdgcn_mfma_f32_32x32x16_bf16(b1, qr[qb][d0], p1, 0, 0, 0); }
            if (near) { const LAS float* lp = lut + (64 * (t - qc + 3) - (32 * qb + r32) + 4 * hi);
#pragma unroll
                for (int r = 0; r < 16; ++r) { const int cb = (r & 3) + 8 * (r >> 2); p0[r] += lp[cb]; p1[r] += lp[32 + cb]; } }
            if (HAS_MASK) { const unsigned wlo = (unsigned)mk[qb] >> (4 * hi), whi = (unsigned)(mk[qb] >> 32) >> (4 * hi);
#pragma unroll
                for (int r = 0; r < 16; ++r) { const int cb = (r & 3) + 8 * (r >> 2); p0[r] = ((wlo >> cb) & 1u) ? p0[r] : NEG; p1[r] = ((whi >> cb) & 1u) ? p1[r] : NEG; } }
            float tm = __builtin_fmaxf(p0[0], p1[0]);
#pragma unroll
            for (int r = 1; r < 16; ++r) tm = __builtin_fmaxf(tm, __builtin_fmaxf(p0[r], p1[r]));
            tm = __builtin_fmaxf(tm, __shfl_xor(tm, 32));
            const float mnew = __builtin_fmaxf(mrun[qb], tm), alpha = __builtin_amdgcn_exp2f(mrun[qb] - mnew);
            mrun[qb] = mnew;
            float sum = 0.f;
#pragma unroll
            for (int r = 0; r < 16; ++r) { p0[r] = __builtin_amdgcn_exp2f(p0[r] - mnew); p1[r] = __builtin_amdgcn_exp2f(p1[r] - mnew); sum += p0[r] + p1[r]; }
            lrun[qb] = lrun[qb] * alpha + sum;
            if (__any(alpha != 1.0f)) {
                if (hi == 0) wsf[32 * qb + r32] = alpha;
#pragma unroll
                for (int r = 0; r < 16; ++r) { const float f = wsf[32 * qb + crow(r, hi)]; o[qb][0][r] *= f; o[qb][1][r] *= f; }
            }
            bf16x8 pa[4];
            { v4u w;
              w.x = pg8::cvt_pk_bf16(p0[0], p0[1]); w.y = pg8::cvt_pk_bf16(p0[2], p0[3]); w.z = pg8::cvt_pk_bf16(p0[4], p0[5]); w.w = pg8::cvt_pk_bf16(p0[6], p0[7]); pa[0] = __builtin_bit_cast(bf16x8, w);
              w.x = pg8::cvt_pk_bf16(p0[8], p0[9]); w.y = pg8::cvt_pk_bf16(p0[10], p0[11]); w.z = pg8::cvt_pk_bf16(p0[12], p0[13]); w.w = pg8::cvt_pk_bf16(p0[14], p0[15]); pa[1] = __builtin_bit_cast(bf16x8, w);
              w.x = pg8::cvt_pk_bf16(p1[0], p1[1]); w.y = pg8::cvt_pk_bf16(p1[2], p1[3]); w.z = pg8::cvt_pk_bf16(p1[4], p1[5]); w.w = pg8::cvt_pk_bf16(p1[6], p1[7]); pa[2] = __builtin_bit_cast(bf16x8, w);
              w.x = pg8::cvt_pk_bf16(p1[8], p1[9]); w.y = pg8::cvt_pk_bf16(p1[10], p1[11]); w.z = pg8::cvt_pk_bf16(p1[12], p1[13]); w.w = pg8::cvt_pk_bf16(p1[14], p1[15]); pa[3] = __builtin_bit_cast(bf16x8, w); }
#pragma unroll
            for (int d0 = 0; d0 < 2; ++d0)
#pragma unroll
                for (int ks = 0; ks < 4; ++ks) {
                    const s16x4 vl = __builtin_bit_cast(s16x4, __builtin_amdgcn_ds_read_tr16_b64_v4i16((LAS s16x4*)(vb + d0 * 4096 + ks * 1024)));
                    const s16x4 vh = __builtin_bit_cast(s16x4, __builtin_amdgcn_ds_read_tr16_b64_v4i16((LAS s16x4*)(vb + d0 * 4096 + ks * 1024 + 512)));
                    const bf16x8 vf = (bf16x8){vl[0], vl[1], vl[2], vl[3], vh[0], vh[1], vh[2], vh[3]};
                    o[qb][d0] = __builtin_amdgcn_mfma_f32_32x32x16_bf16(pa[ks], vf, o[qb][d0], 0, 0, 0);
                }
        }
    }
    int lane = lane_in; asm volatile("" : "+v"(lane));
    const int r32 = lane & 31, hi = lane >> 5;
#pragma unroll
    for (int qb = 0; qb < 2; ++qb) {
        const float lt = lrun[qb] + __shfl_xor(lrun[qb], 32);
        if (hi == 0) wsf[32 * qb + r32] = 1.0f / lt;
#pragma unroll
        for (int r = 0; r < 16; ++r) { const float f = wsf[32 * qb + crow(r, hi)]; bf16* orow = Op + (size_t)(32 * qb + crow(r, hi)) * WA + r32;
            *(GAS bf16*)(orow) = (bf16)f2bf(o[qb][0][r] * f); *(GAS bf16*)(orow + 32) = (bf16)f2bf(o[qb][1][r] * f); }
    }
    LDS_WAIT();
}

__device__ __forceinline__ void attn_phase(const Args& A, LAS unsigned char* lds, int vcu, int G, int wave, int lane, int tid) {
    unsigned char* ws = A.ws;
    Ptrs P; P.QA = (const bf16*)(ws + WS_QA); P.KA = (const bf16*)(ws + WS_KA); P.VA = (const bf16*)(ws + WS_VA); P.QB = (const bf16*)(ws + WS_QB); P.KB = (const bf16*)(ws + WS_KB); P.VB = (const bf16*)(ws + WS_VB);
    P.CKA = (const bf16*)(ws + WS_CKA); P.CVA = (const bf16*)(ws + WS_CVA); P.CKB = (const bf16*)(ws + WS_CKB); P.CVB = (const bf16*)(ws + WS_CVB);
    P.OA = (bf16*)(ws + WS_QA); P.OB = (bf16*)(ws + WS_QB); P.mask = (const u64*)(ws + WS_MASK);
    build_lut(A.in[7], A.in[15], lds, tid);
    __syncthreads();
    for (int j = vcu; j < 256; j += G) { const int b = j >> 6, i = j & 63;
        for (int k = 0; k < 5; ++k) {
            AUnit u;
            if (k == 0) u = AUnit{0, b, 127 - i}; else if (k == 1) u = AUnit{0, b, i}; else if (k == 2) u = AUnit{2, b, 2 * i}; else if (k == 3) u = AUnit{2, b, 2 * i + 1};
            else { if (j < NB_S) u = AUnit{1, j, 16}; else if (j < 2 * NB_S) u = AUnit{3, j - NB_S, 16}; else break; }
            attn_unit(u, P, lds, wave, lane);
        }
    }
    __syncthreads();
}
}

__global__ void __launch_bounds__(NWAVES * 64, 2) fwd_kernel(Args args) {
    extern __shared__ __attribute__((aligned(16))) unsigned char lds_raw[];
    LAS unsigned char* lds = (LAS unsigned char*)lds_raw;
    volatile LAS unsigned* MISC = (volatile LAS unsigned*)(lds + MISC_OFF);
    const int tid = threadIdx.x, lane = tid & 63, wave = __builtin_amdgcn_readfirstlane(tid >> 6);
    const int G = gridDim.x; const int bx = blockIdx.x; const int vcu = (G % 8 == 0) ? (bx % 8) * (G / 8) + bx / 8 : bx;
    unsigned char* ws = args.ws;
    gu32* ctl = (gu32*)(ws + WS_CTL);
    if (tid < 64) MISC[tid] = 0u;
    __syncthreads();
    XcdBarrier bar; bar.bar = (unsigned*)(ctl + CW_BAR); bar.x = 0; bar.st = nullptr;
    if (N_LAUNCHES == 1) bar = xcd_barrier_post((unsigned*)(ctl + CW_BAR), MISC + 8);
    const int lo = args.ph_lo, hi = args.ph_hi;
#ifndef PH_MASK
#define PH_MASK 0xFFFF
#endif
#define IN(k) ((((PH_MASK) >> (k)) & 1) && lo <= (k) && (k) < hi)
#define SEAM(k) do { if (IN(k) && IN((k) + 1)) xcd_barrier(bar); } while (0)
    const int gw = vcu * NWAVES + wave, NGW = G * NWAVES;
    float* out = args.out;
    bf16* XB = (bf16*)(ws + WS_XB); bf16* HBIG = (bf16*)(ws + WS_BIG);
    float* YS = out + O_Y;

    if (IN(0)) { p0_prologue(args, lds, vcu, G, wave, lane, tid); }
    SEAM(0);
    if (IN(1)) {
        pg8::Gemm g{XB, (const bf16*)(ws + WS_W1T), MT, NUP, DM}; pg8::StaticOrder S; S.init(MT, NUP, G, bx);
        pg8::EpiSwiglu E{HBIG};
        pg8::gemm_phase<pg8::EpiSwiglu, pg8::StaticOrder, true, true>(lds, g, S, E);
    }
    SEAM(1);
    if (IN(2)) {
        pg8::Gemm g{HBIG, (const bf16*)(ws + WS_W1O), MT, DM, DFF}; pg8::StaticOrder S; S.init(MT, DM, G, bx);
        pg8::EpiResF32<0> E{args.in[0], args.in[1], nullptr, YS, ALPHA, 0.5f};
        pg8::gemm_phase<pg8::EpiResF32<0>, pg8::StaticOrder, true, true>(lds, g, S, E);
    }
    SEAM(2);
    if (IN(3)) { ln_pass<false>(YS, args.in[8], args.in[9], XB, nullptr, gw, NGW, lane); }
    SEAM(3);
    if (IN(4)) {
        pg8::Gemm g{XB, (const bf16*)(ws + WS_WIN), MT, NINP, DM}; pg8::StaticOrder S; S.init(MT, NINP, G, bx);
        pg8::EpiWin E{(bf16*)(ws + WS_QA), (bf16*)(ws + WS_KA), (bf16*)(ws + WS_VA), (bf16*)(ws + WS_QB), (bf16*)(ws + WS_KB), (bf16*)(ws + WS_VB), (bf16*)(ws + WS_GA), (bf16*)(ws + WS_GB),
                      (bf16*)(ws + WS_QI), (bf16*)(ws + WS_KI), (float*)(ws + WS_WX), out};
        pg8::gemm_phase<pg8::EpiWin, pg8::StaticOrder, true, true>(lds, g, S, E);
    }
    SEAM(4);
    if (IN(5)) { idxp::idx_phase(args, lds, vcu, G, wave, lane, tid); }
    SEAM(5);
    if (IN(6)) { attp::attn_phase(args, lds, vcu, G, wave, lane, tid); }
    SEAM(6);
    if (IN(7)) {
#ifndef P7_PARTS
#define P7_PARTS 3
#endif
        if (P7_PARTS & 1) { pg8::Gemm g{(const bf16*)(ws + WS_QA), (const bf16*)(ws + WS_WBA), MT, DM, WA}; pg8::StaticOrder S; S.init(MT, DM, G, bx);
          pg8::EpiGate<0> E{(const bf16*)(ws + WS_GA), nullptr, (bf16*)(ws + WS_KA)};
          pg8::gemm_phase<pg8::EpiGate<0>, pg8::StaticOrder, true, true>(lds, g, S, E); }
        if (P7_PARTS & 2) { pg8::Gemm g{(const bf16*)(ws + WS_QB), (const bf16*)(ws + WS_WBB), MT, DM, WA}; pg8::StaticOrder S; S.init(MT, DM, G, bx);
          pg8::EpiGate<1> E{(const bf16*)(ws + WS_GB), (const bf16*)(ws + WS_KA), (bf16*)(ws + WS_GA)};
          pg8::gemm_phase<pg8::EpiGate<1>, pg8::StaticOrder, true, true>(lds, g, S, E); }
    }
    SEAM(7);
    if (IN(8)) {
        pg8::Gemm g{(const bf16*)(ws + WS_GA), (const bf16*)(ws + WS_WOUT), MT, DM, DM}; pg8::StaticOrder S; S.init(MT, DM, G, bx);
        pg8::EpiResF32<1> E{nullptr, nullptr, XB, YS, ALPHA, 1.0f};
        pg8::gemm_phase<pg8::EpiResF32<1>, pg8::StaticOrder, true, true>(lds, g, S, E);
    }
    SEAM(8);
    if (IN(9)) { ln_pass<false>(YS, args.in[12], args.in[13], XB, nullptr, gw, NGW, lane); }
    SEAM(9);
    if (IN(10)) {
        pg8::Gemm g{XB, (const bf16*)(ws + WS_W2T), MT, NUP, DM}; pg8::StaticOrder S; S.init(MT, NUP, G, bx);
        pg8::EpiSwiglu E{HBIG};
        pg8::gemm_phase<pg8::EpiSwiglu, pg8::StaticOrder, true, true>(lds, g, S, E);
    }
    SEAM(10);
    if (IN(11)) {
        pg8::Gemm g{HBIG, (const bf16*)(ws + WS_W2O), MT, DM, DFF}; pg8::StaticOrder S; S.init(MT, DM, G, bx);
        pg8::EpiResF32<1> E{nullptr, nullptr, XB, YS, ALPHA, 0.5f};
        pg8::gemm_phase<pg8::EpiResF32<1>, pg8::StaticOrder, true, true>(lds, g, S, E);
    }
    SEAM(11);
    if (IN(12)) { ln_pass<true>(YS, args.in[19], args.in[20], nullptr, YS, gw, NGW, lane); }

#if defined(DBG_DUMP)
    if (lo <= 12 && 12 < hi) {
        const size_t gt = (size_t)gw * 64 + lane, ngt = (size_t)NGW * 64;
        if (DBG_DUMP == 1) { const unsigned* mw = (const unsigned*)(ws + WS_MASK); for (size_t i = gt; i < (size_t)MASK_TILES * 128; i += ngt) YS[i] = (float)__builtin_popcount(mw[i]) + 0.001f * (float)(mw[i] & 1023u); }
        if (DBG_DUMP == 3) { if (gt < 4096) YS[gt] = (float)(__builtin_amdgcn_s_memrealtime() & 0xFFFFFull); }
        if (DBG_DUMP == 5) { const bf16* mx = (const bf16*)(ws + WS_KA); for (size_t i = gt; i < (size_t)MT * DM; i += ngt) YS[i] = pg8::bf2f(mx[i]); }
        if (DBG_DUMP == 4) { const bf16* mx = (const bf16*)(ws + WS_GA); for (size_t i = gt; i < (size_t)MT * DM; i += ngt) YS[i] = pg8::bf2f(mx[i]); }
        if (DBG_DUMP == 2) { const bf16* oa = (const bf16*)(ws + WS_QA); const bf16* ob = (const bf16*)(ws + WS_QB);
            for (size_t i = gt; i < (size_t)MT * WA; i += ngt) { YS[i] = pg8::bf2f(oa[i]); YS[(size_t)MT * WA + i] = pg8::bf2f(ob[i]); } }
    }
#endif
#undef IN
#undef SEAM
}

extern "C" void kernel_launch(void* const* d_in, const int* in_sizes, int n_in, void* d_out, int out_size, void* d_ws, size_t ws_size, hipStream_t stream) {
    static int grid = 0;
    if (grid == 0) {
        if (n_in != 23 || out_size != (int)O_END || ws_size < WS_END) { fprintf(stderr, "kernel_launch: unexpected shapes: n_in %d out %d ws %zu\n", n_in, out_size, ws_size); grid = -1; return; }
        int dev = 0, cus = 0;
        if (hipGetDevice(&dev) != hipSuccess || hipDeviceGetAttribute(&cus, hipDeviceAttributeMultiprocessorCount, dev) != hipSuccess) { grid = -1; return; }
        if (hipFuncSetAttribute((const void*)fwd_kernel, hipFuncAttributeMaxDynamicSharedMemorySize, LDS_BYTES) != hipSuccess) { fprintf(stderr, "kernel_launch: hipFuncSetAttribute failed\n"); grid = -1; return; }
        int per_cu = 0;
        if (hipOccupancyMaxActiveBlocksPerMultiprocessor(&per_cu, (const void*)fwd_kernel, NWAVES * 64, LDS_BYTES) != hipSuccess || per_cu < 1) fprintf(stderr, "kernel_launch: occupancy query says %d\n", per_cu);
        (void)hipGetLastError();
        grid = cus;
    }
    if (grid < 0) return;
    (void)hipMemsetAsync((char*)d_ws + WS_CTL, 0, CTL_ZERO_BYTES, stream);
    Args a{};
    for (int i = 0; i < 23; ++i) a.in[i] = (const float*)d_in[i];
    a.out = (float*)d_out; a.ws = (unsigned char*)d_ws;
    if (N_LAUNCHES == 1) { a.ph_lo = 0; a.ph_hi = N_PHASES; a.li = 0; hipLaunchKernelGGL(fwd_kernel, dim3(grid), dim3(NWAVES * 64), LDS_BYTES, stream, a); }
    else { for (int li = 0; li < N_PHASES; ++li) { a.ph_lo = li; a.ph_hi = li + 1; a.li = li; hipLaunchKernelGGL(fwd_kernel, dim3(grid), dim3(NWAVES * 64), LDS_BYTES, stream, a); } }
}
```

```cpp
#include <hip/hip_runtime.h>
#include <cstdio>
#include <cstdint>

#ifndef MK_N_LAUNCHES
#define MK_N_LAUNCHES 1
#endif

constexpr int DM = 1024, NB_P = 4, SEQ = 8192, NB_S = 8, DSEQ = 64, PAST = 1024, BANDC = 512;
constexpr int MP = NB_P * SEQ;
constexpr int MS = NB_S * DSEQ;
constexpr int MT = MP + MS;
constexpr int DFF = 2816, NUP = 2 * DFF  , NIN = 5444, NINP = 5632;
constexpr int WA = 512;
constexpr float ALPHA = 1.189207115002721f;
constexpr float LN_EPS = 1e-5f;
constexpr float LOG2E = 1.4426950408889634f;
constexpr float C2 = 0.125f * LOG2E;
constexpr size_t O_Y = 0;
constexpr size_t O_KA_P = (size_t)MT * DM;
constexpr size_t O_VA_P = O_KA_P + (size_t)MP * WA;
constexpr size_t O_KI_P = O_VA_P + (size_t)MP * WA;
constexpr size_t O_KB_P = O_KI_P + (size_t)MP * 64;
constexpr size_t O_VB_P = O_KB_P + (size_t)NB_P * BANDC * WA;
constexpr size_t O_KA_S = O_VB_P + (size_t)NB_P * BANDC * WA;
constexpr size_t O_VA_S = O_KA_S + (size_t)MS * WA;
constexpr size_t O_KI_S = O_VA_S + (size_t)MS * WA;
constexpr size_t O_KB_S = O_KI_S + (size_t)MS * 64;
constexpr size_t O_VB_S = O_KB_S + (size_t)NB_S * BANDC * WA;
constexpr size_t O_END = O_VB_S + (size_t)NB_S * BANDC * WA;
static_assert(O_END == 76578816, "output size");

namespace pg8 {
#define PG8_LAS __attribute__((address_space(3)))
typedef unsigned short bf16_t;
typedef short bf16x8 __attribute__((ext_vector_type(8)));
typedef float f32x4 __attribute__((ext_vector_type(4)));
typedef unsigned u32x4 __attribute__((ext_vector_type(4)));
constexpr int BM = 256, BK = 64, HALF = 128, HTB = HALF * BK * 2  , STAGE_BYTES = 8 * HTB, NXCD = 8, WGM = 8;

__host__ __device__ __forceinline__ int lds_byte(int r, int c) { const int st = (r >> 4) * 2 + (c >> 5), rr = r & 15, cc = c & 31, ob = rr * 64 + cc * 2; return st * 1024 + (ob ^ (((ob >> 9) & 1) << 5)); }
__host__ __device__ __forceinline__ void stage_rc(int b, int& R, int& C) { const int st = b / 1024, sb = b % 1024, swz = sb ^ (((sb >> 9) & 1) << 5); R = (st >> 1) * 16 + swz / 64; C = (st & 1) * 32 + (swz % 64) / 2; }
__host__ __device__ __forceinline__ int perm32(int rho) { const int n = rho >> 4, i = rho & 15; return 8 * (i >> 2) + 4 * n + (i & 3); }

struct Unit { int pm, pn; int ko = 0; };
struct Gemm { const bf16_t* A; const bf16_t* Bt; int M, N, K; int ld = 0; };

struct StaticOrder {
    int nM, nN, nwg, G, c;
    __host__ __device__ void init(int M, int N, int G_, int c_) { nM = M / BM; nN = N / BM; nwg = nM * nN; G = G_; c = c_; }
    __host__ __device__ bool next(int i, Unit& u) const {
        const long L = (long)i * G + c; if (L >= nwg) return false;
        int wgid = (int)L; { const int q = nwg / NXCD, r = nwg % NXCD, xcd = wgid % NXCD, off = wgid / NXCD; wgid = (xcd < r ? xcd * (q + 1) : r * (q + 1) + (xcd - r) * q) + off; }
        const int nig = WGM * nN, gid = wgid / nig, fm = gid * WGM, gsz = (nM - fm) < WGM ? (nM - fm) : WGM;
        u.pm = fm + ((wgid % nig) % gsz); u.pn = (wgid % nig) / gsz; return true;
    }
    __device__ __forceinline__ void a_ready(const Unit&) const {}
    __device__ __forceinline__ void done(const Unit&) const {}
};

typedef float f32x2_cv __attribute__((ext_vector_type(2))); typedef __bf16 bf16x2_cv __attribute__((ext_vector_type(2)));
__device__ __forceinline__ unsigned cvt_pk_bf16(float lo, float hi) { const f32x2_cv v = {lo, hi}; const bf16x2_cv b = __builtin_convertvector(v, bf16x2_cv); return __builtin_bit_cast(unsigned, b); }
typedef float f32x2 __attribute__((ext_vector_type(2)));

typedef unsigned u32x2 __attribute__((ext_vector_type(2)));
__device__ __forceinline__ float bf2f(unsigned short b) { return __uint_as_float((unsigned)b << 16); }
__device__ __forceinline__ float sigmoidf_fast(float x) { return __builtin_amdgcn_rcpf(1.0f + __builtin_amdgcn_exp2f(-x * LOG2E)); }
__device__ __forceinline__ f32x4 unpack_lo(u32x4 w) { return (f32x4){__uint_as_float(w.x << 16), __uint_as_float(w.x & 0xffff0000u), __uint_as_float(w.y << 16), __uint_as_float(w.y & 0xffff0000u)}; }
__device__ __forceinline__ f32x4 unpack_hi(u32x4 w) { return (f32x4){__uint_as_float(w.z << 16), __uint_as_float(w.z & 0xffff0000u), __uint_as_float(w.w << 16), __uint_as_float(w.w & 0xffff0000u)}; }
__device__ __forceinline__ u32x4 pack8(f32x4 v0, f32x4 v1) { u32x4 w; w.x = cvt_pk_bf16(v0[0], v0[1]); w.y = cvt_pk_bf16(v0[2], v0[3]); w.z = cvt_pk_bf16(v1[0], v1[1]); w.w = cvt_pk_bf16(v1[2], v1[3]); return w; }

struct EpiSwiglu {
    static constexpr bool PERM = true, AFTER_DRAIN = false;
    bf16_t* H;
    __device__ __forceinline__ void operator()(const f32x4 (&acc)[2][2][4][2], const Unit& u, int wr, int wc, int fr, int fq) const {
        const int row0 = u.pm * BM + wr * 64 + fr, col0 = u.pn * 128 + wc * 32 + 8 * fq;
#pragma unroll
        for (int ai = 0; ai < 2; ++ai)
#pragma unroll
            for (int m = 0; m < 4; ++m) {
                f32x4 h[2];
#pragma unroll
                for (int n = 0; n < 2; ++n) { const f32x4 a = acc[ai][0][m][n], g = acc[ai][1][m][n];
#pragma unroll
                    for (int j = 0; j < 4; ++j) h[n][j] = a[j] * sigmoidf_fast(a[j]) * g[j]; }
                *(u32x4*)(H + (size_t)(row0 + ai * HALF + m * 16) * DFF + col0) = pack8(h[0], h[1]);
            }
    }
};

template <int RES> struct EpiResF32 {
    static constexpr bool PERM = false, AFTER_DRAIN = false;
    const float* xp; const float* xs; const bf16_t* rb; float* out; float alpha, scale;
    __device__ __forceinline__ void operator()(const f32x4 (&acc)[2][2][4][2], const Unit& u, int wr, int wc, int fr, int fq) const {
        const int row0 = u.pm * BM + wr * 64 + fr, col0 = u.pn * BM + wc * 32 + 4 * fq;
#pragma unroll
        for (int ai = 0; ai < 2; ++ai)
#pragma unroll
            for (int m = 0; m < 4; ++m) { const int row = row0 + ai * HALF + m * 16;
                const float* xr = (row < MP) ? xp + (size_t)row * DM : xs + (size_t)(row - MP) * DM;
#pragma unroll
                for (int bj = 0; bj < 2; ++bj)
#pragma unroll
                    for (int n = 0; n < 2; ++n) { const int c = col0 + bj * HALF + n * 16; f32x4 r;
                        if (RES == 0) r = *(const f32x4*)(xr + c);
                        else { const u32x2 w = *(const u32x2*)(rb + (size_t)row * DM + c); r = (f32x4){__uint_as_float(w.x << 16), __uint_as_float(w.x & 0xffff0000u), __uint_as_float(w.y << 16), __uint_as_float(w.y & 0xffff0000u)}; }
                        *(f32x4*)(out + (size_t)row * DM + c) = r * alpha + acc[ai][bj][m][n] * scale; }
            }
    }
};

template <int ADD> struct EpiGate {
    static constexpr bool PERM = true, AFTER_DRAIN = false;
    const bf16_t* G; const bf16_t* PREV; bf16_t* OUT;
    __device__ __forceinline__ void operator()(const f32x4 (&acc)[2][2][4][2], const Unit& u, int wr, int wc, int fr, int fq) const {
        const int row0 = u.pm * BM + wr * 64 + fr, col0 = u.pn * BM + wc * 32 + 8 * fq;
#pragma unroll
        for (int ai = 0; ai < 2; ++ai)
#pragma unroll
            for (int m = 0; m < 4; ++m)
#pragma unroll
                for (int bj = 0; bj < 2; ++bj) { const size_t off = (size_t)(row0 + ai * HALF + m * 16) * DM + col0 + bj * HALF;
                    const u32x4 g = *(const u32x4*)(G + off);
                    f32x4 v0 = unpack_lo(g) * acc[ai][bj][m][0], v1 = unpack_hi(g) * acc[ai][bj][m][1];
                    if (ADD) { const u32x4 p = *(const u32x4*)(PREV + off); v0 += unpack_lo(p); v1 += unpack_hi(p); }
                    *(u32x4*)(OUT + off) = pack8(v0, v1); }
    }
};

struct EpiWin {
    static constexpr bool PERM = true, AFTER_DRAIN = false;
    bf16_t *QA, *KA, *VA, *QB, *KB, *VB, *GA, *GB, *QI, *KI; float* WX; float* out;
    __device__ __forceinline__ void operator()(const f32x4 (&acc)[2][2][4][2], const Unit& u, int wr, int wc, int fr, int fq) const {
        const int pn = u.pn, row0 = u.pm * BM + wr * 64 + fr, cl = wc * 32 + 8 * fq;
        const bool sample = (u.pm >= MP / BM);
        if (pn < 12) {
            const int grp = pn >> 1;
            bf16_t* dst = grp == 0 ? QA : grp == 1 ? KA : grp == 2 ? VA : grp == 3 ? QB : grp == 4 ? KB : VB;
            const float sc = (grp == 0 || grp == 3) ? C2 : 1.0f;
            const int cb = (pn & 1) * 256 + cl;
            const bool fa = (grp == 1 || grp == 2), fb = (grp == 4 || grp == 5);
            const bool wf = fa || (fb && (sample || (u.pm & 31) >= 30));
            size_t obase = 0;
            if (fa) obase = sample ? (grp == 1 ? O_KA_S : O_VA_S) : (grp == 1 ? O_KA_P : O_VA_P);
            if (fb) obase = sample ? (grp == 4 ? O_KB_S : O_VB_S) : (grp == 4 ? O_KB_P : O_VB_P);
#pragma unroll
            for (int ai = 0; ai < 2; ++ai)
#pragma unroll
                for (int m = 0; m < 4; ++m) { const int row = row0 + ai * HALF + m * 16;
                    size_t orow = 0;
                    if (fa) orow = sample ? (size_t)(row - MP) : (size_t)row;
                    if (fb) { if (sample) { const int s = row - MP; orow = (size_t)((s >> 6) * BANDC + (BANDC - DSEQ) + (s & 63)); } else { orow = (size_t)((row >> 13) * BANDC + ((row & (SEQ - 1)) - (SEQ - BANDC))); } }
#pragma unroll
                    for (int bj = 0; bj < 2; ++bj) { const f32x4 v0 = acc[ai][bj][m][0], v1 = acc[ai][bj][m][1];
                        *(u32x4*)(dst + (size_t)row * WA + cb + bj * HALF) = pack8(v0 * sc, v1 * sc);
                        if (wf) { float* o = out + obase + orow * WA + cb + bj * HALF; *(f32x4*)o = v0; *(f32x4*)(o + 4) = v1; } }
                }
        } else if (pn < 20) {
            bf16_t* dst = pn < 16 ? GA : GB; const int cb = ((pn - 12) & 3) * 256 + cl;
#pragma unroll
            for (int ai = 0; ai < 2; ++ai)
#pragma unroll
                for (int m = 0; m < 4; ++m) { const int row = row0 + ai * HALF + m * 16;
#pragma unroll
                    for (int bj = 0; bj < 2; ++bj) { f32x4 v0 = acc[ai][bj][m][0], v1 = acc[ai][bj][m][1];
#pragma unroll
                        for (int j = 0; j < 4; ++j) { v0[j] = sigmoidf_fast(v0[j]); v1[j] = sigmoidf_fast(v1[j]); }
                        *(u32x4*)(dst + (size_t)row * DM + cb + bj * HALF) = pack8(v0, v1); }
                }
        } else if (pn == 20) {
#pragma unroll
            for (int ai = 0; ai < 2; ++ai)
#pragma unroll
                for (int m = 0; m < 4; ++m) { const int row = row0 + ai * HALF + m * 16;
#pragma unroll
                    for (int bj = 0; bj < 2; ++bj) *(u32x4*)(QI + (size_t)row * 256 + cl + bj * HALF) = pack8(acc[ai][bj][m][0], acc[ai][bj][m][1]); }
        } else {
            const size_t ob = sample ? O_KI_S : O_KI_P;
#pragma unroll
            for (int ai = 0; ai < 2; ++ai)
#pragma unroll
                for (int m = 0; m < 4; ++m) { const int row = row0 + ai * HALF + m * 16; const f32x4 v0 = acc[ai][0][m][0], v1 = acc[ai][0][m][1];
                    if (cl < 64) { *(u32x4*)(KI + (size_t)row * 64 + cl) = pack8(v0, v1);
                        float* o = out + ob + (size_t)(sample ? row - MP : row) * 64 + cl; *(f32x4*)o = v0; *(f32x4*)(o + 4) = v1; }
                    else if (cl == 64) *(f32x4*)(WX + (size_t)row * 4) = v0;
                }
        }
    }
};


struct SplitOrder {
    int nsplit, kelems, c;
    __device__ __forceinline__ bool next(int i, Unit& u) const { if (i != 0 || c >= 8 * nsplit) return false; const int ks = c % nsplit, t = c / nsplit; u.pn = t & 3; u.pm = MP / BM + (t >> 2); u.ko = ks * kelems * 2; return true; }
    __device__ __forceinline__ void a_ready(const Unit&) const {}
    __device__ __forceinline__ void done(const Unit&) const {}
};
struct EpiSlab {
    static constexpr bool PERM = false, AFTER_DRAIN = false;
    float* slab; int kelems;
    __device__ __forceinline__ void operator()(const f32x4 (&acc)[2][2][4][2], const Unit& u, int wr, int wc, int fr, int fq) const {
        const int ks = u.ko / (kelems * 2); const int row0 = (u.pm - MP / BM) * BM + wr * 64 + fr, col0 = u.pn * BM + wc * 32 + 4 * fq;
        float* base = slab + (size_t)ks * MS * DM;
#pragma unroll
        for (int ai = 0; ai < 2; ++ai)
#pragma unroll
            for (int m = 0; m < 4; ++m)
#pragma unroll
                for (int bj = 0; bj < 2; ++bj)
#pragma unroll
                    for (int n = 0; n < 2; ++n) *(f32x4*)(base + (size_t)(row0 + ai * HALF + m * 16) * DM + col0 + bj * HALF + n * 16) = acc[ai][bj][m][n];
    }
};
template <class Epi, class Sched, bool ALIGN_EPI = false, bool SP2 = false>
__device__ __forceinline__ void gemm_phase(PG8_LAS unsigned char* lds, const Gemm g, const Sched& S, const Epi& E) {
    const int tid = threadIdx.x, wid = __builtin_amdgcn_readfirstlane(tid >> 6), lane = tid & 63, wr = wid >> 2, wc = wid & 3, fr = lane & 15, fq = lane >> 4;
    const int K = g.K, nt = K / BK, LD = g.ld ? g.ld : g.K;
    unsigned voffA[2], voffB[2];
#pragma unroll
    for (int i = 0; i < 2; ++i) { int R, C; stage_rc(tid * 16 + i * 8192, R, C); const int Rb = Epi::PERM ? ((R & ~31) + perm32(R & 31)) : R;
        voffA[i] = (unsigned)(R * LD + C) * 2u; voffB[i] = (unsigned)(Rb * LD + C) * 2u; }
    const size_t kstep = (size_t)(BK * 2);
    const size_t hstep = (size_t)HALF * LD * 2;
    const size_t tstep = 2 * hstep;
    const unsigned ldsw = (unsigned)wid * 1024u;
    const int aoff = lds_byte(wr * 64 + fr, fq * 8), boff = lds_byte(wc * 32 + fr, fq * 8);
#define PG8_SA(b, h) (((b) * 2 + (h)) * HTB)
#define PG8_SB(b, h) ((4 + (b) * 2 + (h)) * HTB)
#define PG8_STAGE(bufoff, gbase, voff) do { _Pragma("unroll") for (int _i = 0; _i < 2; ++_i) \
        __builtin_amdgcn_global_load_lds((const unsigned*)((const char*)(gbase) + (voff)[_i]), (PG8_LAS unsigned*)(lds + (bufoff) + ldsw + _i * 8192), 16, 0, 0); } while (0)
#define PG8_LDA(dst, b, h) do { _Pragma("unroll") for (int m = 0; m < 4; ++m) _Pragma("unroll") for (int k = 0; k < 2; ++k) dst[m][k] = *(const PG8_LAS bf16x8*)(lds + PG8_SA(b, h) + aoff + m * 2048 + k * 1024); } while (0)
#define PG8_LDB(dst, b, h) do { _Pragma("unroll") for (int n = 0; n < 2; ++n) _Pragma("unroll") for (int k = 0; k < 2; ++k) dst[n][k] = *(const PG8_LAS bf16x8*)(lds + PG8_SB(b, h) + boff + n * 2048 + k * 1024); } while (0)
#define PG8_MMA(ai, bj, At, Bt) do { __builtin_amdgcn_s_setprio(1); _Pragma("unroll") for (int m = 0; m < 4; ++m) _Pragma("unroll") for (int n = 0; n < 2; ++n) _Pragma("unroll") for (int k = 0; k < 2; ++k) \
        acc[ai][bj][m][n] = __builtin_amdgcn_mfma_f32_16x16x32_bf16(Bt[n][k], At[m][k], acc[ai][bj][m][n], 0, 0, 0); __builtin_amdgcn_s_setprio(0); } while (0)
#define PG8_WAIT_V(n) asm volatile("s_waitcnt vmcnt(" #n ")" ::: "memory")
#define PG8_WAIT_L(n) asm volatile("s_waitcnt lgkmcnt(" #n ")" ::: "memory")
#define PG8_BAR __builtin_amdgcn_s_barrier()
#define PG8_SCHED __builtin_amdgcn_sched_barrier(0)
    Unit cur, nxt; int ui = 0;
    if (!S.next(0, cur)) return;
    f32x4 acc[2][2][4][2];
#pragma unroll
    for (int a = 0; a < 2; ++a)
#pragma unroll
        for (int b = 0; b < 2; ++b)
#pragma unroll
            for (int m = 0; m < 4; ++m)
#pragma unroll
                for (int n = 0; n < 2; ++n) acc[a][b][m][n] = (f32x4){0.f, 0.f, 0.f, 0.f};
    bf16x8 At[4][2], B0[2][2], B1[2][2];
    const char* cA = (const char*)g.A + (size_t)cur.pm * tstep + cur.ko; const char* cB = (const char*)g.Bt + (size_t)cur.pn * tstep + cur.ko;
    S.a_ready(cur);
    if constexpr (SP2) {
        PG8_STAGE(PG8_SB(0, 0), cB, voffB); PG8_STAGE(PG8_SB(0, 1), cB + hstep, voffB); PG8_STAGE(PG8_SA(0, 0), cA, voffA); PG8_STAGE(PG8_SA(0, 1), cA + hstep, voffA);
        if (wr == 1) PG8_BAR;
        PG8_WAIT_V(2); PG8_BAR;
        PG8_STAGE(PG8_SB(1, 0), cB + kstep, voffB); PG8_STAGE(PG8_SA(1, 0), cA + kstep, voffA); PG8_STAGE(PG8_SB(1, 1), cB + hstep + kstep, voffB);
        PG8_WAIT_V(6); PG8_BAR;
    } else {
        PG8_STAGE(PG8_SB(0, 0), cB, voffB); PG8_STAGE(PG8_SA(0, 0), cA, voffA); PG8_STAGE(PG8_SB(0, 1), cB + hstep, voffB); PG8_STAGE(PG8_SA(0, 1), cA + hstep, voffA);
        if (wr == 1) PG8_BAR;
        PG8_WAIT_V(4); PG8_BAR;
        PG8_STAGE(PG8_SB(1, 0), cB + kstep, voffB); PG8_STAGE(PG8_SA(1, 0), cA + kstep, voffA); PG8_STAGE(PG8_SB(1, 1), cB + hstep + kstep, voffB);
        PG8_WAIT_V(6); PG8_BAR;
    }
    for (;;) {
        const bool has_next = S.next(ui + 1, nxt);
        const char* nA = has_next ? (const char*)g.A + (size_t)nxt.pm * tstep + nxt.ko : cA; const char* nB = has_next ? (const char*)g.Bt + (size_t)nxt.pn * tstep + nxt.ko : cB;
        for (int t = 0; t < nt; t += 2) {
            const bool last = (t == nt - 2);
            const char* a1 = cA + (size_t)(t + 1) * kstep;
            const char* a2 = last ? nA : cA + (size_t)(t + 2) * kstep; const char* b2 = last ? nB : cB + (size_t)(t + 2) * kstep;
            const char* a3 = a2 + kstep; const char* b3 = b2 + kstep;
            if (last && has_next) S.a_ready(nxt);
            if constexpr (SP2) {
            PG8_LDB(B0, 0, 0); PG8_LDB(B1, 0, 1); PG8_SCHED; PG8_LDA(At, 0, 0); PG8_STAGE(PG8_SA(1, 1), a1 + hstep, voffA);
            PG8_WAIT_V(8); PG8_WAIT_L(0); PG8_BAR; PG8_MMA(0, 0, At, B0); PG8_MMA(0, 1, At, B1); PG8_BAR; PG8_SCHED;
            PG8_LDA(At, 0, 1); PG8_STAGE(PG8_SB(0, 0), b2, voffB); PG8_STAGE(PG8_SB(0, 1), b2 + hstep, voffB); PG8_STAGE(PG8_SA(0, 0), a2, voffA);
            PG8_WAIT_V(8); PG8_WAIT_L(0); PG8_BAR; PG8_MMA(1, 0, At, B0); PG8_MMA(1, 1, At, B1); PG8_BAR; PG8_SCHED;
            PG8_LDB(B0, 1, 0); PG8_LDB(B1, 1, 1); PG8_SCHED; PG8_LDA(At, 1, 0); PG8_STAGE(PG8_SA(0, 1), a2 + hstep, voffA);
            PG8_WAIT_V(8); PG8_WAIT_L(0); PG8_BAR; PG8_MMA(0, 0, At, B0); PG8_MMA(0, 1, At, B1); PG8_BAR; PG8_SCHED;
            PG8_LDA(At, 1, 1); PG8_STAGE(PG8_SB(1, 0), b3, voffB); PG8_STAGE(PG8_SB(1, 1), b3 + hstep, voffB); PG8_STAGE(PG8_SA(1, 0), a3, voffA);
            PG8_WAIT_V(8); PG8_WAIT_L(0); PG8_BAR; PG8_MMA(1, 0, At, B0); PG8_MMA(1, 1, At, B1); PG8_BAR; PG8_SCHED;
            } else {
            PG8_LDB(B0, 0, 0); PG8_SCHED; PG8_LDA(At, 0, 0); PG8_STAGE(PG8_SA(1, 1), a1 + hstep, voffA);
            PG8_WAIT_L(8); PG8_BAR; PG8_WAIT_L(0); PG8_MMA(0, 0, At, B0); PG8_BAR; PG8_SCHED;
            PG8_LDB(B1, 0, 1); PG8_STAGE(PG8_SB(0, 0), b2, voffB);
            PG8_BAR; PG8_WAIT_L(0); PG8_MMA(0, 1, At, B1); PG8_BAR;
            PG8_LDA(At, 0, 1); PG8_STAGE(PG8_SA(0, 0), a2, voffA);
            PG8_BAR; PG8_WAIT_L(0); PG8_MMA(1, 0, At, B0); PG8_BAR; PG8_SCHED;
            PG8_STAGE(PG8_SB(0, 1), b2 + hstep, voffB);
            PG8_WAIT_V(6); PG8_BAR; PG8_MMA(1, 1, At, B1); PG8_BAR;
            PG8_LDB(B0, 1, 0); PG8_SCHED; PG8_LDA(At, 1, 0); PG8_STAGE(PG8_SA(0, 1), a2 + hstep, voffA);
            PG8_WAIT_L(8); PG8_BAR; PG8_WAIT_L(0); PG8_MMA(0, 0, At, B0); PG8_BAR; PG8_SCHED;
            PG8_LDB(B1, 1, 1); PG8_STAGE(PG8_SB(1, 0), b3, voffB);
            PG8_BAR; PG8_WAIT_L(0); PG8_MMA(0, 1, At, B1); PG8_BAR;
            PG8_LDA(At, 1, 1); PG8_STAGE(PG8_SA(1, 0), a3, voffA);
            PG8_BAR; PG8_WAIT_L(0); PG8_MMA(1, 0, At, B0); PG8_BAR; PG8_SCHED;
            PG8_STAGE(PG8_SB(1, 1), b3 + hstep, voffB);
            PG8_WAIT_V(6); PG8_BAR; PG8_MMA(1, 1, At, B1); PG8_BAR;
            }
        }
        if constexpr (ALIGN_EPI) { if (wr == 0) PG8_BAR; }
        if constexpr (!Epi::AFTER_DRAIN) { E(acc, cur, wr, wc, fr, fq); S.done(cur); }
        if (!has_next) break;
#pragma unroll
        for (int a = 0; a < 2; ++a)
#pragma unroll
            for (int b = 0; b < 2; ++b)
#pragma unroll
                for (int m = 0; m < 4; ++m)
#pragma unroll
                    for (int n = 0; n < 2; ++n) acc[a][b][m][n] = (f32x4){0.f, 0.f, 0.f, 0.f};
        cur = nxt; cA = nA; cB = nB; ++ui;
        if constexpr (ALIGN_EPI) { if (wr == 1) PG8_BAR; }
    }
    PG8_WAIT_V(0);
    if constexpr (!ALIGN_EPI) { if (wr == 0) PG8_BAR; }
    PG8_BAR;
    if constexpr (Epi::AFTER_DRAIN) { E.fused(acc, cur, wr, wc, fr, fq, lds, wid, lane); S.done(cur); }
#undef PG8_SA
#undef PG8_SB
#undef PG8_STAGE
#undef PG8_LDA
#undef PG8_LDB
#undef PG8_MMA
#undef PG8_WAIT_V
#undef PG8_WAIT_L
#undef PG8_BAR
#undef PG8_SCHED
}
}
#define GAS __attribute__((address_space(1)))
#define LAS __attribute__((address_space(3)))
typedef unsigned short bf16;
typedef unsigned v4u __attribute__((ext_vector_type(4)));
typedef float f32x4 __attribute__((ext_vector_type(4)));
typedef short bf16x8 __attribute__((ext_vector_type(8)));
typedef GAS unsigned gu32;
typedef GAS unsigned long long gu64;
#define RLX_AGENT __ATOMIC_RELAXED, __HIP_MEMORY_SCOPE_AGENT
#define LDS_WAIT() asm volatile("s_waitcnt lgkmcnt(0)" ::: "memory")
#define VM_WAIT() asm volatile("s_waitcnt vmcnt(0)" ::: "memory")
__device__ __forceinline__ unsigned long long rt() { return __builtin_amdgcn_s_memrealtime(); }
__device__ __forceinline__ unsigned f2bf(float f) { unsigned u = __builtin_bit_cast(unsigned, f); return (u + 0x7fffu + ((u >> 16) & 1u)) >> 16; }
__device__ __forceinline__ unsigned pk2(float lo, float hi) { return f2bf(lo) | (f2bf(hi) << 16); }

#define XB_TMO      128
#define XB_XCNT(j)  (256  + 64 * (j))
#define XB_XSUB(j)  (1280 + 64 * (j))
#define XB_XGEN(j)  (2304 + 64 * (j))
#define XB_TOP      3328
#define XB_TOPGEN   3392
#define XCD_BAR_WORDS 3456
#define XB_SPIN_CAP (1u << 18)

__device__ __forceinline__ unsigned xb_ld(unsigned* p)              { return __hip_atomic_load(p, __ATOMIC_RELAXED, __HIP_MEMORY_SCOPE_AGENT); }
__device__ __forceinline__ unsigned xb_add(unsigned* p, unsigned v) { return __hip_atomic_fetch_add(p, v, __ATOMIC_RELAXED, __HIP_MEMORY_SCOPE_AGENT); }
__device__ __forceinline__ unsigned xb_xcc_id() { return (unsigned)__builtin_amdgcn_s_getreg((3 << 11) | 20) & 0xFu; }
#define XB_SPIN(cond, bar) do { unsigned _sp = 0; while (cond) { __builtin_amdgcn_s_sleep(1); \
    if ((++_sp & 255u) == 0u) { if (xb_ld(&(bar)[XB_TMO])) break; if (_sp > XB_SPIN_CAP) { atomicAdd(&(bar)[XB_TMO], 1u); break; } } } } while (0)

struct XcdBarrier {
    unsigned* bar; unsigned x;
    volatile LAS unsigned* st;
};

__device__ __forceinline__ XcdBarrier xcd_barrier_post(unsigned* bar, volatile LAS unsigned* st) {
    XcdBarrier b; b.bar = bar; b.x = xb_xcc_id(); b.st = st;
    if (threadIdx.x == 0) (void)xb_add(&bar[XB_XCNT(b.x)], 1u);
    return b;
}
__device__ __forceinline__ void xcd_barrier_complete(unsigned* bar, unsigned x, unsigned& nloc, unsigned& nx) {
    const unsigned G = gridDim.x * gridDim.y * gridDim.z;
    unsigned sum, cnt, mine, sp = 0u;
    for (;;) {
        sum = 0u; cnt = 0u; mine = 0u;
#pragma unroll
        for (unsigned j = 0; j < 16; ++j) { const unsigned c = xb_ld(&bar[XB_XCNT(j)]); sum += c; cnt += (c > 0u) ? 1u : 0u; mine = (j == x) ? c : mine; }
        if (sum == G) break;
        __builtin_amdgcn_s_sleep(1);
        if ((++sp & 255u) == 0u) { if (xb_ld(&bar[XB_TMO])) break; if (sp > XB_SPIN_CAP) { atomicAdd(&bar[XB_TMO], 1u); break; } }
    }
    nloc = mine > 0u ? mine : 1u; nx = cnt > 0u ? cnt : 1u;
}

__device__ __forceinline__ void xcd_barrier(const XcdBarrier& b) {
    asm volatile("s_waitcnt vmcnt(0)" ::: "memory");
    __syncthreads();
    if (threadIdx.x == 0) {
        unsigned* bar = b.bar;
        __builtin_amdgcn_s_waitcnt(0);
        unsigned nloc = b.st[0], nx = b.st[1];
        if (nloc == 0u) { xcd_barrier_complete(bar, b.x, nloc, nx); b.st[0] = nloc; b.st[1] = nx; }
        const unsigned old = xb_add(&bar[XB_XSUB(b.x)], 1u);
        const unsigned gen = old / nloc;
        if (old + 1u == (gen + 1u) * nloc) {
            __builtin_amdgcn_fence(__ATOMIC_RELEASE, "agent");
            asm volatile("s_waitcnt vmcnt(0)" ::: "memory");
            const unsigned og = xb_add(&bar[XB_TOP], 1u);
            const unsigned tg = og / nx;
            if (og + 1u == (tg + 1u) * nx) xb_add(&bar[XB_TOPGEN], 1u);
            else XB_SPIN(xb_ld(&bar[XB_TOPGEN]) == tg, bar);
            __builtin_amdgcn_fence(__ATOMIC_ACQUIRE, "agent");
            xb_add(&bar[XB_XGEN(b.x)], 1u);
            asm volatile("s_waitcnt vmcnt(0)" ::: "memory");
        } else {
            XB_SPIN(xb_ld(&bar[XB_XGEN(b.x)]) == gen, bar);
            __builtin_amdgcn_fence(__ATOMIC_ACQUIRE, "agent");
            asm volatile("s_waitcnt vmcnt(0)" ::: "memory");
        }
    }
    __syncthreads();
}

constexpr int NWAVES = 8;
constexpr int N_LAUNCHES = MK_N_LAUNCHES;
constexpr int N_PHASES = 13;
typedef float f32x16 __attribute__((ext_vector_type(16)));
typedef short s16x4 __attribute__((ext_vector_type(4)));
typedef unsigned long long u64;

constexpr size_t MiB = 1u << 20;
constexpr size_t WS_CTL = 0, CTL_ZERO_BYTES = 65536;
constexpr int CW_BAR = 4096;
constexpr size_t WS_W1T = 2 * MiB;
constexpr size_t WS_W1O = 13 * MiB;
constexpr size_t WS_WIN = 19 * MiB;
constexpr size_t WS_WBA = 30 * MiB, WS_WBB = 31 * MiB;
constexpr size_t WS_WOUT = 32 * MiB;
constexpr size_t WS_W2T = 34 * MiB, WS_W2O = 45 * MiB;
constexpr size_t WS_CKA = 51 * MiB, WS_CVA = 59 * MiB;
constexpr size_t WS_CKI = 67 * MiB;
constexpr size_t WS_CKB = 68 * MiB, WS_CVB = 72 * MiB;
constexpr size_t WS_WX = 76 * MiB;
constexpr size_t WS_MASK = 77 * MiB;
constexpr size_t WS_XB = 94 * MiB;
constexpr size_t WS_BIG = 159 * MiB;
constexpr size_t SZ_512 = (size_t)MT * WA * 2;
constexpr size_t WS_QA = WS_BIG, WS_KA = WS_QA + SZ_512, WS_VA = WS_KA + SZ_512, WS_QB = WS_VA + SZ_512, WS_KB = WS_QB + SZ_512, WS_VB = WS_KB + SZ_512;
constexpr size_t WS_GA = WS_VB + SZ_512, WS_GB = WS_GA + (size_t)MT * DM * 2;
constexpr size_t WS_QI = WS_GB + (size_t)MT * DM * 2, WS_KI = WS_QI + (size_t)MT * 256 * 2, WS_END = WS_KI + (size_t)MT * 64 * 2;
static_assert(WS_END <= 512 * MiB, "workspace map");
static_assert(WS_BIG + (size_t)MT * DFF * 2 <= WS_GA, "FFN hidden must not reach the gate/mix region");
constexpr int MASK_TILES_P = NB_P * (128 * 129 / 2);
constexpr int MASK_TILES = MASK_TILES_P + NB_S * 17;
static_assert(WS_MASK + (size_t)MASK_TILES * 512 <= WS_XB, "mask region");

constexpr int LDS_BYTES = 163840;
constexpr int MISC_OFF = 163840 - 256;

struct Args {
    const float* in[23]; float* out; unsigned char* ws; int ph_lo, ph_hi, li, pad;
};
typedef const __attribute__((address_space(4))) Args* KArgsPtr;
__device__ __forceinline__ Args load_args() {
    KArgsPtr kp = (KArgsPtr)__builtin_amdgcn_kernarg_segment_ptr();
    asm volatile("" : "+s"(kp));
    Args a;
#pragma unroll
    for (int i = 0; i < 23; ++i) a.in[i] = kp->in[i];
    a.out = kp->out; a.ws = kp->ws; a.ph_lo = kp->ph_lo; a.ph_hi = kp->ph_hi; a.li = kp->li; a.pad = kp->pad;
    return a;
}

__device__ __forceinline__ float wave_sum(float v) {
#pragma unroll
    for (int o = 1; o < 64; o <<= 1) v += __shfl_xor(v, o);
    return v;
}
__device__ __forceinline__ void tr_item(const float* W, int K, int Nsrc, bf16* WT, int drow0, int scol0, int nvalid, LAS float* scr, int kb, int lane) {
    const int k0 = 64 * kb, j = lane & 31;
#pragma unroll 8
    for (int i = 0; i < 32; ++i) { const int kk = 2 * i + (lane >> 5); scr[kk * 33 + j] = (j < nvalid) ? W[(size_t)(k0 + kk) * Nsrc + scol0 + j] : 0.f; }
    LDS_WAIT(); asm volatile("" ::: "memory");
    const int c = lane & 7;
#pragma unroll
    for (int jj = 0; jj < 4; ++jj) { const int n = (lane >> 3) + 8 * jj; const LAS float* s = scr + (8 * c) * 33 + n;
        v4u o; o.x = pk2(s[0 * 33], s[1 * 33]); o.y = pk2(s[2 * 33], s[3 * 33]); o.z = pk2(s[4 * 33], s[5 * 33]); o.w = pk2(s[6 * 33], s[7 * 33]);
        *(GAS v4u*)(WT + (size_t)(drow0 + n) * K + k0 + 8 * c) = o; }
    LDS_WAIT(); asm volatile("" ::: "memory");
}
__device__ __forceinline__ int up_src(int g) { const int pn = g >> 3, j0 = (g & 7) * 32; return (j0 < 128) ? 128 * pn + j0 : DFF + 128 * pn + (j0 - 128); }
__device__ __forceinline__ void win_src(int g, int& s0, int& nv) {
    const int d0 = 32 * g; nv = 32;
    if (d0 < 1536) s0 = d0;
    else if (d0 < 3072) s0 = 1860 + (d0 - 1536);
    else if (d0 < 5120) s0 = 3396 + (d0 - 3072);
    else if (d0 < 5376) s0 = 1536 + (d0 - 5120);
    else if (d0 < 5440) s0 = 1792 + (d0 - 5376);
    else if (d0 == 5440) { s0 = 1856; nv = 4; }
    else { s0 = 0; nv = 0; }
}
__device__ __forceinline__ void cvt_flat(const float* src, bf16* dst, size_t n8, size_t gt, size_t ngt) {
    for (size_t i = gt; i < n8; i += ngt) { const f32x4 a = *(const GAS f32x4*)(src + i * 8), b = *(const GAS f32x4*)(src + i * 8 + 4);
        v4u o; o.x = pk2(a.x, a.y); o.y = pk2(a.z, a.w); o.z = pk2(b.x, b.y); o.w = pk2(b.z, b.w); *(GAS v4u*)(dst + i * 8) = o; }
}

__device__ __forceinline__ void p0_prologue(const Args& A, LAS unsigned char* lds, int part, int wg, int nwg, int wave, int lane, int tid) {
    const int vcu = wg, G = nwg;
    unsigned char* ws = A.ws;
    LAS float* scr = (LAS float*)(lds + wave * 16384);
    const int gw = vcu * NWAVES + wave, NGW = G * NWAVES;
    const float *ffn1_wi = A.in[10], *ffn1_wo = A.in[11], *w_in = A.in[14], *wba = A.in[16], *wbb = A.in[17], *wout = A.in[18], *ffn2_wi = A.in[21], *ffn2_wo = A.in[22];
    constexpr int I_UP = 16 * 176, I_DN = 44 * 32, I_IN = 16 * 176, I_BR = 8 * 32, I_OUT = 16 * 32;
    constexpr int NITEMS = 2 * I_UP + 2 * I_DN + I_IN + 2 * I_BR + I_OUT;
    for (int it = gw; it < NITEMS; it += NGW) {
        int r = it;
        const int cls = (r < I_UP) ? 0 : (r < 2 * I_UP) ? 2 : (r < 2 * I_UP + I_DN) ? 0 : (r < 2 * I_UP + 2 * I_DN) ? 3 : 1; if (cls != part) continue;
        if (r < I_UP) { const int kb = r / 176, g = r % 176; tr_item(ffn1_wi, DM, NUP, (bf16*)(ws + WS_W1T), 32 * g, up_src(g), 32, scr, kb, lane); continue; } r -= I_UP;
        if (r < I_UP) { const int kb = r / 176, g = r % 176; tr_item(ffn2_wi, DM, NUP, (bf16*)(ws + WS_W2T), 32 * g, up_src(g), 32, scr, kb, lane); continue; } r -= I_UP;
        if (r < I_DN) { const int kb = r / 32, g = r % 32; tr_item(ffn1_wo, DFF, DM, (bf16*)(ws + WS_W1O), 32 * g, 32 * g, 32, scr, kb, lane); continue; } r -= I_DN;
        if (r < I_DN) { const int kb = r / 32, g = r % 32; tr_item(ffn2_wo, DFF, DM, (bf16*)(ws + WS_W2O), 32 * g, 32 * g, 32, scr, kb, lane); continue; } r -= I_DN;
        if (r < I_IN) { const int kb = r / 176, g = r % 176; int s0, nv; win_src(g, s0, nv); tr_item(w_in, DM, NIN, (bf16*)(ws + WS_WIN), 32 * g, s0, nv, scr, kb, lane); continue; } r -= I_IN;
        if (r < I_BR) { const int kb = r / 32, g = r % 32; tr_item(wba, WA, DM, (bf16*)(ws + WS_WBA), 32 * g, 32 * g, 32, scr, kb, lane); continue; } r -= I_BR;
        if (r < I_BR) { const int kb = r / 32, g = r % 32; tr_item(wbb, WA, DM, (bf16*)(ws + WS_WBB), 32 * g, 32 * g, 32, scr, kb, lane); continue; } r -= I_BR;
        { const int kb = r / 32, g = r % 32; tr_item(wout, DM, DM, (bf16*)(ws + WS_WOUT), 32 * g, 32 * g, 32, scr, kb, lane); }
    }
#if defined(DBG_PREFILL)
    { const size_t gt_ = (size_t)(vcu * NWAVES + wave) * 64 + lane, ngt_ = (size_t)G * NWAVES * 64; GAS v4u* gz = (GAS v4u*)(ws + WS_GA); for (size_t i = gt_; i < (size_t)MT * DM * 2 * 2 / 16; i += ngt_) gz[i] = (v4u){0x3F803F80u, 0x3F803F80u, 0x3F803F80u, 0x3F803F80u}; }
#endif
    const size_t gt = (size_t)(vcu * NWAVES + wave) * 64 + lane, ngt = (size_t)G * NWAVES * 64;
    if (part == 0) {
    cvt_flat(A.in[0], (bf16*)(ws + WS_XB), (size_t)MP * DM / 8, gt, ngt);
    cvt_flat(A.in[1], (bf16*)(ws + WS_XB) + (size_t)MP * DM, (size_t)MS * DM / 8, gt, ngt);
    return; }
    if (part == 3) return;
    if (part == 2) {
    cvt_flat(A.in[2], (bf16*)(ws + WS_CKA), (size_t)NB_S * PAST * WA / 8, gt, ngt);
    cvt_flat(A.in[3], (bf16*)(ws + WS_CVA), (size_t)NB_S * PAST * WA / 8, gt, ngt);
    return; }
    cvt_flat(A.in[4], (bf16*)(ws + WS_CKI), (size_t)NB_S * PAST * 64 / 8, gt, ngt);
    cvt_flat(A.in[5], (bf16*)(ws + WS_CKB), (size_t)NB_S * BANDC * WA / 8, gt, ngt);
    cvt_flat(A.in[6], (bf16*)(ws + WS_CVB), (size_t)NB_S * BANDC * WA / 8, gt, ngt);
    { constexpr size_t PER = (size_t)(BANDC - DSEQ) * WA / 4;
      for (size_t i = gt; i < 2 * NB_S * PER; i += ngt) { const int which = (int)(i / (NB_S * PER)); const size_t r = i % (NB_S * PER); const int b = (int)(r / PER); const size_t e = (r % PER) * 4;
          const float* src = A.in[which ? 6 : 5] + ((size_t)b * BANDC + DSEQ) * WA + e; float* dst = A.out + (which ? O_VB_S : O_KB_S) + (size_t)b * BANDC * WA + e;
          *(GAS f32x4*)dst = *(const GAS f32x4*)src; } }
}

template <bool F32OUT> __device__ __forceinline__ void ln_pass(const float* src, const float* g, const float* b, bf16* dstb, float* dstf, int gw, int NGW, int lane, int mrows = MT) {
    f32x4 gv[4], bv[4];
#pragma unroll
    for (int j = 0; j < 4; ++j) { gv[j] = *((const GAS f32x4*)g + lane + 64 * j); bv[j] = *((const GAS f32x4*)b + lane + 64 * j); }
    for (int m = gw; m < mrows; m += NGW) {
        const GAS f32x4* xr = (const GAS f32x4*)(src + (size_t)m * DM) + lane;
        f32x4 v[4]; float s = 0.f;
#pragma unroll
        for (int j = 0; j < 4; ++j) { v[j] = xr[64 * j]; s += (v[j].x + v[j].y) + (v[j].z + v[j].w); }
        const float mean = wave_sum(s) * (1.f / DM); float s2 = 0.f;
#pragma unroll
        for (int j = 0; j < 4; ++j) { v[j] = v[j] - mean; s2 += (v[j].x * v[j].x + v[j].y * v[j].y) + (v[j].z * v[j].z + v[j].w * v[j].w); }
        const float rstd = 1.f / sqrtf(wave_sum(s2) * (1.f / DM) + LN_EPS);
#pragma unroll
        for (int j = 0; j < 4; ++j) { v[j] = v[j] * rstd * gv[j] + bv[j]; }
        if (F32OUT) { GAS f32x4* o = (GAS f32x4*)(dstf + (size_t)m * DM) + lane;
#pragma unroll
            for (int j = 0; j < 4; ++j) o[64 * j] = v[j];
        } else { GAS unsigned long long* o8 = (GAS unsigned long long*)(dstb + (size_t)m * DM) + lane;
#pragma unroll
            for (int j = 0; j < 4; ++j) o8[64 * j] = (unsigned long long)pk2(v[j].x, v[j].y) | ((unsigned long long)pk2(v[j].z, v[j].w) << 32); }
    }
}

template <bool F32OUT> __device__ __forceinline__ void ln_pass_sample(const float* slab, int nsplit, float scale, const bf16* res, float alpha, const float* g, const float* b, bf16* dstb, float* dstf, int gw, int NGW, int lane, const float* resf = nullptr  ) {
    for (int r = gw; r < MS; r += NGW) { const int m = MP + r;
        f32x4 v[4]; float s = 0.f;
#pragma unroll
        for (int j = 0; j < 4; ++j) { f32x4 a = (f32x4){0.f, 0.f, 0.f, 0.f};
            for (int ks = 0; ks < nsplit; ++ks) a += *((const GAS f32x4*)(slab + ((size_t)ks * MS + r) * DM) + lane + 64 * j);
            f32x4 rr;
            if (resf) rr = *((const GAS f32x4*)(resf + (size_t)r * DM) + lane + 64 * j);
            else { const unsigned long long w = *((const GAS unsigned long long*)(res + (size_t)m * DM) + lane + 64 * j);
                rr = (f32x4){__uint_as_float((unsigned)w << 16), __uint_as_float((unsigned)w & 0xffff0000u), __uint_as_float((unsigned)(w >> 32) << 16), __uint_as_float((unsigned)(w >> 32) & 0xffff0000u)}; }
            v[j] = rr * alpha + a * scale; s += (v[j].x + v[j].y) + (v[j].z + v[j].w); }
        const float mean = wave_sum(s) * (1.f / DM); float s2 = 0.f;
#pragma unroll
        for (int j = 0; j < 4; ++j) { v[j] = v[j] - mean; s2 += (v[j].x * v[j].x + v[j].y * v[j].y) + (v[j].z * v[j].z + v[j].w * v[j].w); }
        const float rstd = 1.f / sqrtf(wave_sum(s2) * (1.f / DM) + LN_EPS);
#pragma unroll
        for (int j = 0; j < 4; ++j) { const f32x4 gv = *((const GAS f32x4*)g + lane + 64 * j), bv = *((const GAS f32x4*)b + lane + 64 * j); v[j] = v[j] * rstd * gv + bv; }
        if (F32OUT) { GAS f32x4* o = (GAS f32x4*)(dstf + (size_t)m * DM) + lane;
#pragma unroll
            for (int j = 0; j < 4; ++j) o[64 * j] = v[j];
        } else { GAS unsigned long long* o8 = (GAS unsigned long long*)(dstb + (size_t)m * DM) + lane;
#pragma unroll
            for (int j = 0; j < 4; ++j) o8[64 * j] = (unsigned long long)pk2(v[j].x, v[j].y) | ((unsigned long long)pk2(v[j].z, v[j].w) << 32); }
    }
}

namespace idxp {
#ifndef IDX_CAP
#define IDX_CAP 160
#endif
constexpr int NBIN = 1024, CAP = IDX_CAP, NSEL = 256;
constexpr int L_HIST = 0;
constexpr int L_LMASK = 65536;
constexpr int L_PSUM = 131072;
constexpr int L_BSTAR = L_PSUM + 2048;
constexpr int L_CABOVE = L_BSTAR + 256;
constexpr int L_NCAND = L_CABOVE + 256;
struct IUnit { int kind, b, c; };

__device__ __forceinline__ float relu_f(float x) { return __builtin_amdgcn_fmed3f(x, 0.f, 3.0e38f); }
__device__ __forceinline__ float mul1(float a, float b) { float r; asm("v_mul_f32 %0, %1, %2" : "=v"(r) : "v"(a), "v"(b)); return r; }
__device__ __forceinline__ float fma1(float a, float b, float c) { float r; asm("v_fma_f32 %0, %1, %2, %3" : "=v"(r) : "v"(a), "v"(b), "v"(c)); return r; }
__device__ __forceinline__ float score4(const f32x4 (&d)[4], int reg, const float (&w)[4]) {
    float r = mul1(w[0], relu_f(d[0][reg]));
    r = fma1(w[1], relu_f(d[1][reg]), r);
    r = fma1(w[2], relu_f(d[2][reg]), r);
    r = fma1(w[3], relu_f(d[3][reg]), r);
    return r;
}
__device__ __forceinline__ int sbin(float s, float invsig, float, int kidx) {
    const float x = mul1(s, invsig);
    const unsigned xb = __float_as_uint(x);
    const int t = (int)((xb >> 18) & 0x1fffu), t2 = (int)((xb >> 19) & 0xfffu);
    int m = (t - 2000) > t2 ? (t - 2000) : t2;
    m = m < 1808 ? 1808 : (m > 2191 ? 2191 : m);
    const int sm = (int)xb >> 31;
    const int bin = (((m - 1808) ^ sm) + 512) + (sm << 7);
    return (x == 0.f) ? (511 - (kidx >> 6)) : bin;
}
__device__ __forceinline__ unsigned skey(float s) { unsigned b = __float_as_uint(s); if ((b << 1) == 0u) b = 0u; return b ^ ((b >> 31) ? 0xFFFFFFFFu : 0x80000000u); }
__device__ __forceinline__ const bf16* ki_tile(const IUnit& u, int t, const bf16* KI, const bf16* CKI) {
    if (u.kind == 0) return KI + (size_t)(u.b * SEQ + 64 * t) * 64;
    return (t < 16) ? CKI + (size_t)(u.b * PAST + 64 * t) * 64 : KI + (size_t)(MP + u.b * DSEQ) * 64;
}
__device__ __forceinline__ int mask_tile_base(int kind, int b, int c) { return kind == 0 ? b * (128 * 129 / 2) + c * (c + 1) / 2 : MASK_TILES_P + b * 17; }

__device__ __forceinline__ unsigned bin_edge_key(int target, float isg) {
    if (target > NBIN - 1) return 0xFF800001u;
    unsigned lo_k = 0u, hi_k = 0xFF800000u;
    for (int it = 0; it < 33; ++it) { if (lo_k >= hi_k) break; const unsigned mid = lo_k + ((hi_k - lo_k) >> 1);
        const unsigned fb = (mid & 0x80000000u) ? (mid ^ 0x80000000u) : ~mid; const float sv = __uint_as_float(fb);
        const int bv = (sv == 0.f) ? 511 : sbin(sv, isg, 0.f, 0);
        if (bv >= target) hi_k = mid; else lo_k = mid + 1u; }
    return lo_k;
}
template <int MODE, int ABL = 0, bool ZR = true> __device__ __forceinline__ void idx_sweep(const IUnit& u, const bf16* KI, const bf16* CKI, const bf16x8 (&Bq)[4][2], const float (&wsc)[4], float lo, float inv, int bstar,
                                                            LAS unsigned char* lds, unsigned* maskw, int wave, int lane, float tsel = 0.f, float tcand = 0.f, int zt = -1) {
    const int qb = wave & 3, kp = wave >> 2, nt = u.c + 1;
    asm volatile("" : "+v"(tsel), "+v"(tcand), "+v"(zt), "+v"(lo));
    LAS unsigned* hist = (LAS unsigned*)(lds + L_HIST); LAS unsigned* candk = (LAS unsigned*)(lds + L_HIST); LAS unsigned short* candi = (LAS unsigned short*)(lds + L_HIST + 64 * CAP * 4); LAS unsigned* ncand = (LAS unsigned*)(lds + L_NCAND);
    bf16x8 An[2][2];
    unsigned voff = (unsigned)((((32 * kp + (lane & 15)) * 64) + 8 * (lane >> 4)) * 2); asm volatile("" : "+v"(voff));
    { const bf16* Kt = ki_tile(u, 0, KI, CKI);
#pragma unroll
      for (int kbi = 0; kbi < 2; ++kbi)
#pragma unroll
          for (int ks = 0; ks < 2; ++ks) An[kbi][ks] = *(const GAS bf16x8*)((const GAS char*)Kt + voff + (kbi * 2048 + ks * 64)); }
    for (int t = 0; t < nt; ++t) {
        int ln_ = lane; asm volatile("" : "+v"(ln_));
        const int l15 = ln_ & 15, lg = ln_ >> 4, qloc = 16 * qb + l15;
        bf16x8 Ac[2][2];
#pragma unroll
        for (int kbi = 0; kbi < 2; ++kbi)
#pragma unroll
            for (int ks = 0; ks < 2; ++ks) Ac[kbi][ks] = An[kbi][ks];
        if (t + 1 < nt) { const bf16* Kt = ki_tile(u, t + 1, KI, CKI);
#pragma unroll
            for (int kbi = 0; kbi < 2; ++kbi)
#pragma unroll
                for (int ks = 0; ks < 2; ++ks) An[kbi][ks] = *(const GAS bf16x8*)((const GAS char*)Kt + voff + (kbi * 2048 + ks * 64)); }
        const bool zs = (zt >= 0) && (t < zt), zc = (zt >= 0) && (t == zt); const u64 zcm = __builtin_amdgcn_ballot_w64(zc);
#pragma unroll
        for (int kbi = 0; kbi < 2; ++kbi) {
            f32x4 d[4];
#pragma unroll
            for (int hh = 0; hh < 4; ++hh) { d[hh] = __builtin_amdgcn_mfma_f32_16x16x32_bf16(Ac[kbi][0], Bq[hh][0], (f32x4){0.f, 0.f, 0.f, 0.f}, 0, 0, 0);
                                             d[hh] = __builtin_amdgcn_mfma_f32_16x16x32_bf16(Ac[kbi][1], Bq[hh][1], d[hh], 0, 0, 0); }
            unsigned nib = 0u; u64 cmv[4] = {0ull, 0ull, 0ull, 0ull}; float sv[4] = {0.f, 0.f, 0.f, 0.f};
#pragma unroll
            for (int reg = 0; reg < 4; ++reg) {
                const float s = score4(d, reg, wsc);
                const unsigned kidx = (unsigned)(64 * t + 32 * kp + 16 * kbi + 4 * lg + reg);
                if (MODE == 0) {
                    const float x = mul1(s, lo); const unsigned xb = __float_as_uint(x);
                    const int tt = (int)((xb >> 18) & 0x1fffu), t2 = (int)((xb >> 19) & 0xfffu);
                    int m = (tt - 2000) > t2 ? (tt - 2000) : t2; m = m < 1808 ? 1808 : (m > 2191 ? 2191 : m);
                    const int w = (x == 0.f) ? (511 - t) : (m - 1808);
                    const unsigned val = (x < 0.f) ? 0x10000u : 1u;
                    if (ABL == 2) { asm volatile("" :: "v"(w), "v"(val)); }
                    else __hip_atomic_fetch_add(hist + qloc * 512 + (w ^ (qloc & 31)), val, __ATOMIC_RELAXED, __HIP_MEMORY_SCOPE_WORKGROUP);
                } else if (MODE == 2) {
                    if (zt == -2 && s >= tcand && !(s >= tsel)) __hip_atomic_fetch_add(ncand + 64 + qloc, 1u, __ATOMIC_RELAXED, __HIP_MEMORY_SCOPE_WORKGROUP);
                } else {
                    const bool a = s >= tsel, b = s >= tcand, z = ZR && (s == 0.f);
                    const bool sel = ZR ? (a || (z && zs)) : a;
                    nib |= (sel ? 1u : 0u) << reg;
                    cmv[reg] = ZR ? ((__builtin_amdgcn_ballot_w64(a) ^ __builtin_amdgcn_ballot_w64(b)) | (__builtin_amdgcn_ballot_w64(z) & zcm)) : (__builtin_amdgcn_ballot_w64(a) ^ __builtin_amdgcn_ballot_w64(b));
                    sv[reg] = s;
                }
            }
            if (MODE == 1) {
                if (__builtin_expect((cmv[0] | cmv[1] | cmv[2] | cmv[3]) != 0ull, 0)) {
#pragma unroll
                    for (int reg = 0; reg < 4; ++reg) if (cmv[reg] != 0ull) { if ((cmv[reg] >> ln_) & 1ull) { const unsigned kidx = (unsigned)(64 * t + 32 * kp + 16 * kbi + 4 * lg + reg);
                        const unsigned pos = __hip_atomic_fetch_add(ncand + qloc, 1u, __ATOMIC_RELAXED, __HIP_MEMORY_SCOPE_WORKGROUP);
                        if (pos < (unsigned)CAP) { candk[qloc * CAP + pos] = skey(sv[reg]); candi[qloc * CAP + pos] = (unsigned short)kidx; } } } } }
            if (MODE == 1) { if (nib) __hip_atomic_fetch_or((LAS unsigned*)(lds + L_LMASK) + (t * 64 + qloc) * 2 + kp, nib << (4 * lg + 16 * kbi), __ATOMIC_RELAXED, __HIP_MEMORY_SCOPE_WORKGROUP); }
        }
    }
}

template <int ABL> __device__ __forceinline__ void idx_unit(const IUnit& u, const bf16* QI, const bf16* KI, const bf16* CKI, const float* WX, unsigned* dbgw, unsigned* maskall, LAS unsigned char* lds, int wave, int lane, int tid) {
    const int nt = u.c + 1, L = 64 * nt;
    unsigned* maskw = maskall + (size_t)mask_tile_base(u.kind, u.b, u.c) * 128;
    if (L <= NSEL) {
        if (ABL == 0) for (int i = tid; i < nt * 128; i += NWAVES * 64) maskw[i] = 0xFFFFFFFFu;
        return;
    }
    const int qb = wave & 3, l15 = lane & 15, lg = lane >> 4, qloc = 16 * qb + l15;
    const int m0 = (u.kind == 0) ? u.b * SEQ + 64 * u.c : MP + u.b * DSEQ;
    bf16x8 Bq[4][2]; float wsc[4], nrm2[4];
#pragma unroll
    for (int hh = 0; hh < 4; ++hh) { float a = 0.f;
#pragma unroll
        for (int ks = 0; ks < 2; ++ks) { Bq[hh][ks] = *(const GAS bf16x8*)(QI + (size_t)(m0 + qloc) * 256 + hh * 64 + ks * 32 + 8 * lg);
#pragma unroll
            for (int j = 0; j < 8; ++j) { const float x = __uint_as_float((unsigned)(unsigned short)Bq[hh][ks][j] << 16); a += x * x; } }
        a += __shfl_xor(a, 16); a += __shfl_xor(a, 32); nrm2[hh] = a;
        wsc[hh] = WX[(size_t)(m0 + qloc) * 4 + hh] * 0.0625f; }
    float sig2 = 0.f, mu = 0.f;
#pragma unroll
    for (int hh = 0; hh < 4; ++hh) { sig2 += wsc[hh] * wsc[hh] * nrm2[hh]; mu += wsc[hh] * sqrtf(nrm2[hh]); }
    const float sig = sqrtf(__builtin_fmaxf(sig2, 1e-30f)); mu *= 0.3989423f;
    const float lo = 1.0f / sig, inv = 0.f; (void)mu;
    if (lg == 0 && (wave >> 2) == 0) ((LAS float*)(lds + L_NCAND + 2560))[qloc] = lo;
    LAS unsigned* hist = (LAS unsigned*)(lds + L_HIST); LAS unsigned* psum = (LAS unsigned*)(lds + L_PSUM);
    LAS int* bst = (LAS int*)(lds + L_BSTAR); LAS int* cab = (LAS int*)(lds + L_CABOVE); LAS unsigned* ncand = (LAS unsigned*)(lds + L_NCAND);
    LAS unsigned* psum2 = (LAS unsigned*)(lds + L_NCAND + 512);
    idx_sweep<0, ABL>(u, KI, CKI, Bq, wsc, lo, inv, 0, lds, maskw, wave, lane);
    __syncthreads();
    if (ABL == 1 || ABL == 2) { LAS v4u* z = (LAS v4u*)(lds + L_HIST); for (int i = tid; i < 131072 / 16; i += NWAVES * 64) z[i] = (v4u){0u, 0u, 0u, 0u}; __syncthreads(); return; }
    const int fq = tid >> 3, fj = tid & 7;
#define HIST_COUNT(B) ({ const int B_ = (B); const int w_ = B_ >= 512 ? B_ - 512 : (B_ >= 384 ? B_ : 383 - B_); const unsigned x_ = hist[fq * 512 + (w_ ^ (fq & 31))]; (int)(B_ >= 384 ? (x_ & 0xffffu) : (x_ >> 16)); })
    { unsigned sacc = 0u;
      if (fj < 7) {
          const int wbase = (fj >= 4) ? 128 * (fj - 4) : (fj == 3 ? 384 : 128 * (2 - fj)); const bool lowh = fj >= 3;
          const LAS v4u* hp = (const LAS v4u*)(hist + fq * 512 + wbase);
          for (int i = 0; i < 32; ++i) { const v4u x = hp[(i + lane) & 31];
              sacc += lowh ? ((x.x & 0xffffu) + (x.y & 0xffffu)) + ((x.z & 0xffffu) + (x.w & 0xffffu)) : ((x.x >> 16) + (x.y >> 16)) + ((x.z >> 16) + (x.w >> 16)); } }
      psum[fq * 8 + fj] = sacc; }
    __syncthreads();
    int P = 0, cumP = 0;
    { int cum = 0; bool hit = false;
      for (int pp = 7; pp >= 0; --pp) { const int sv = (int)psum[fq * 8 + pp]; if (!hit && cum + sv >= NSEL) { P = pp; cumP = cum; hit = true; } if (!hit) cum += sv; } }
    { int sacc = 0;
      for (int i = 0; i < 16; ++i) sacc += HIST_COUNT(128 * P + 16 * fj + i);
      psum2[fq * 8 + fj] = (unsigned)sacc; }
    __syncthreads();
    { int cum = cumP, O = 0; bool hit = false;
      for (int oo = 7; oo >= 0; --oo) { const int sv = (int)psum2[fq * 8 + oo]; if (!hit && cum + sv >= NSEL) { O = oo; hit = true; } if (!hit) cum += sv; }
      int bstar = 0;
      if (fj == O) {
          for (int B = 128 * P + 16 * O + 15; B >= 128 * P + 16 * O; --B) { const int cn = HIST_COUNT(B); if (cum + cn >= NSEL) { bstar = B; break; } cum += cn; }
#undef HIST_COUNT
          bst[fq] = bstar; cab[fq] = cum; ncand[fq] = 0u; }
      bstar = __shfl(bstar, (lane & ~7) | O);
      const bool zreg = (bstar >= 384 && bstar <= 511);
      const unsigned kpos = 0x80000001u;
      if (fj == O) { const float isg = ((LAS float*)(lds + L_NCAND + 2560))[fq];
          const unsigned kc = zreg ? kpos : bin_edge_key(bstar, isg);
          ((LAS float*)(lds + L_NCAND + 2816))[fq] = __uint_as_float((kc & 0x80000000u) ? (kc ^ 0x80000000u) : ~kc);
          ((LAS int*)(lds + L_NCAND + 3328))[fq] = zreg ? (511 - bstar) : -1; }
      if (fj == (O ^ 1)) { const float isg = ((LAS float*)(lds + L_NCAND + 2560))[fq];
          const unsigned ksel = zreg ? kpos : bin_edge_key(bstar + 1, isg);
          ((LAS float*)(lds + L_NCAND + 3072))[fq] = (ksel > 0xFF800000u) ? __builtin_inff() : __uint_as_float((ksel & 0x80000000u) ? (ksel ^ 0x80000000u) : ~ksel); } }
    __syncthreads();
    if (ABL == 4) { __syncthreads(); LAS v4u* z = (LAS v4u*)(lds + L_HIST); for (int i = tid; i < 131072 / 16; i += NWAVES * 64) z[i] = (v4u){0u, 0u, 0u, 0u}; __syncthreads(); return; }
    LAS float* tcs = (LAS float*)(lds + L_NCAND + 2816); LAS float* tss = (LAS float*)(lds + L_NCAND + 3072); LAS int* zts = (LAS int*)(lds + L_NCAND + 3328);
    LAS unsigned* ovfw = (LAS unsigned*)(lds + L_NCAND + 3584);
    for (int round = 0; round < 40; ++round) {
        { LAS v4u* z = (LAS v4u*)(lds + L_LMASK); for (int i = tid; i < 65536 / 16; i += NWAVES * 64) z[i] = (v4u){0u, 0u, 0u, 0u}; }
        if (tid == 0) ovfw[0] = 0u;
        __syncthreads();
        const int bstar = bst[qloc];
    { const int ztq = ((LAS int*)(lds + L_NCAND + 3328))[qloc]; const float tsq = ((LAS float*)(lds + L_NCAND + 3072))[qloc], tcq = ((LAS float*)(lds + L_NCAND + 2816))[qloc];
      if (__builtin_amdgcn_ballot_w64(ztq >= 0) != 0ull) idx_sweep<1, 0, true>(u, KI, CKI, Bq, wsc, lo, inv, bstar, lds, maskw, wave, lane, tsq, tcq, ztq);
      else idx_sweep<1, 0, false>(u, KI, CKI, Bq, wsc, lo, inv, bstar, lds, maskw, wave, lane, tsq, tcq, ztq); }
    if (ABL == 3) { __syncthreads(); LAS v4u* z = (LAS v4u*)(lds + L_HIST); for (int i = tid; i < 131072 / 16; i += NWAVES * 64) z[i] = (v4u){0u, 0u, 0u, 0u}; __syncthreads(); return; }
    __syncthreads();
    if (ABL != 5)
    { const int q = tid >> 3, j = tid & 7; LAS unsigned* ck = (LAS unsigned*)(lds + L_HIST) + q * CAP; LAS unsigned short* ci = (LAS unsigned short*)(lds + L_HIST + 64 * CAP * 4) + q * CAP; LAS unsigned* lmask = (LAS unsigned*)(lds + L_LMASK);
#ifdef DBG_NCAND
      if (j == 0) { atomicMax(dbgw + 8, ncand[q]); if (ncand[q] >= (unsigned)CAP) atomicAdd(dbgw + 9, 1u); atomicAdd(dbgw + 10, 1u); }
#endif
      int n = (int)(ncand[q] < (unsigned)CAP ? ncand[q] : (unsigned)CAP); const int need = NSEL - cab[q]; if (ABL == 7) n = n < 8 ? n : 8;
      for (int i = j; i < n; i += 8) { const u64 Ci = ((u64)ck[i] << 13) | (u64)(8191u - ci[i]); int r = 0;
          for (int k = 0; k < n; ++k) r += ((((u64)ck[k] << 13) | (u64)(8191u - ci[k])) > Ci) ? 1 : 0;
          if (r < need) { const unsigned kidx = ci[i]; const int tt = (int)(kidx >> 6), kk = (int)(kidx & 63u);
              __hip_atomic_fetch_or(lmask + (tt * 64 + q) * 2 + (kk >> 5), 1u << (kk & 31), __ATOMIC_RELAXED, __HIP_MEMORY_SCOPE_WORKGROUP); } } }
        __syncthreads();
        if (ABL != 0) break;
        { const int q = tid >> 3, j = tid & 7;
          if (j == 0 && ncand[q] > (unsigned)CAP && zts[q] == -1) { ovfw[0] = 1u; zts[q] = -2; } }
        __syncthreads();
        if (ovfw[0] == 0u) break;
        { const int q = tid >> 3, j = tid & 7;
          if (j == 0) { ncand[64 + q] = 0u;
              if (zts[q] == -2) { const float fc = tcs[q], fs = tss[q]; const unsigned kc = skey(fc), ks = (fs == __builtin_inff()) ? 0xFF800001u : skey(fs);
                  const unsigned km = kc + ((ks - kc) >> 1);
                  ((LAS unsigned*)(lds + L_NCAND + 3840))[q] = km;
                  ((LAS float*)(lds + L_NCAND + 4096))[q] = __uint_as_float((km & 0x80000000u) ? (km ^ 0x80000000u) : ~km); } } }
        __syncthreads();
        idx_sweep<2>(u, KI, CKI, Bq, wsc, lo, inv, 0, lds, maskw, wave, lane, tss[qloc], ((LAS float*)(lds + L_NCAND + 4096))[qloc], zts[qloc]);
        __syncthreads();
        { const int q = tid >> 3, j = tid & 7;
          if (j == 0 && zts[q] == -2) { const int cnt = (int)ncand[64 + q], need = NSEL - cab[q]; const unsigned km = ((LAS unsigned*)(lds + L_NCAND + 3840))[q];
              const float fm = ((LAS float*)(lds + L_NCAND + 4096))[q];
              if (skey(tcs[q]) == km) { zts[q] = -3; }
              else if (cnt >= need) { tcs[q] = fm; zts[q] = -1; }
              else { tss[q] = fm; cab[q] += cnt; zts[q] = -1; } } }
        __syncthreads();
    }
    if (ABL != 6 && ABL != 7) { const LAS v4u* src = (const LAS v4u*)(lds + L_LMASK); GAS v4u* dst = (ABL == 5) ? (GAS v4u*)(maskall + (size_t)MASK_TILES * 128) : (GAS v4u*)maskw; for (int i = tid; i < nt * 32; i += NWAVES * 64) dst[i] = src[i]; }
    __syncthreads();
    { LAS v4u* z = (LAS v4u*)(lds + L_HIST); for (int i = tid; i < 131072 / 16; i += NWAVES * 64) z[i] = (v4u){0u, 0u, 0u, 0u}; }
    __syncthreads();
}

template <int ABL> __device__ __forceinline__ void idx_phase(const Args& A, LAS unsigned char* lds, int vcu, int G, int wave, int lane, int tid) {
    unsigned char* ws = A.ws;
    const bf16 *QI = (const bf16*)(ws + WS_QI), *KI = (const bf16*)(ws + WS_KI), *CKI = (const bf16*)(ws + WS_CKI); const float* WX = (const float*)(ws + WS_WX);
    unsigned* maskall = (unsigned*)(ws + WS_MASK);
    { LAS v4u* z = (LAS v4u*)(lds + L_HIST); for (int i = tid; i < 131072 / 16; i += NWAVES * 64) z[i] = (v4u){0u, 0u, 0u, 0u}; }
    __syncthreads();
    for (int j = vcu; j < 256; j += G) { const int b = j >> 6, i = j & 63;
        int cbig = 127 - i, samp = -1;
        if (i >= 10 && i <= 28) cbig = 128 - i; else if (i == 9) { cbig = 99; samp = 2 * b; }
        else if (i >= 33 && i <= 51) cbig = 128 - i; else if (i == 32) { cbig = 76; samp = 2 * b + 1; }
        IUnit u{0, b, cbig}; idx_unit<ABL>(u, QI, KI, CKI, WX, (unsigned*)(ws + WS_CTL), maskall, lds, wave, lane, tid);
        IUnit v{0, b, i}; idx_unit<ABL>(v, QI, KI, CKI, WX, (unsigned*)(ws + WS_CTL), maskall, lds, wave, lane, tid);
        if (samp >= 0) { IUnit w{1, samp, 16}; idx_unit<ABL>(w, QI, KI, CKI, WX, (unsigned*)(ws + WS_CTL), maskall, lds, wave, lane, tid); } }
}
}

namespace attp {
constexpr int L_SCR = 131072;
constexpr int L_LUT = L_SCR + 4096;
constexpr int L_REDO = L_LUT + 16384;
constexpr int NSTB = 9, STB_BYTES = 16384, L_BLUT = NSTB * STB_BYTES;
constexpr int L_MLUT = L_REDO + 128;
typedef __bf16 bf16v2 __attribute__((ext_vector_type(2)));
struct AUnit { int kind, b, c, desc; };
struct Ptrs { const bf16 *QA, *KA, *VA, *QB, *KB, *VB, *CKA, *CVA, *CKB, *CVB; bf16 *OA, *OB; const u64* mask; };
__device__ __forceinline__ int crow(int r, int hi) { return (r & 3) + 8 * (r >> 2) + 4 * hi; }
__device__ __forceinline__ void glds16(const void* gsrc, unsigned lds_dst) { unsigned keep;
    asm volatile("s_mov_b32 %0, m0\n\ts_mov_b32 m0, %2\n\ts_nop 0\n\tglobal_load_lds_dwordx4 %1, off\n\ts_mov_b32 m0, %0" : "=&s"(keep) : "v"(gsrc), "s"(lds_dst) : "memory"); }
__device__ __forceinline__ void glds16s(unsigned voff, const void* sbase, unsigned lds_dst) { unsigned keep;
    asm volatile("s_mov_b32 %0, m0\n\ts_mov_b32 m0, %3\n\ts_nop 0\n\tglobal_load_lds_dwordx4 %1, %2\n\ts_mov_b32 m0, %0" : "=&s"(keep) : "v"(voff), "s"(sbase), "s"(lds_dst) : "memory"); }
__device__ __forceinline__ unsigned lds_addr(const LAS void* p) { return (unsigned)(uintptr_t)p; }

__device__ __forceinline__ void build_lut(const float* t5, const float* relb, LAS unsigned char* lds, int tid) {
    LAS float* lut = (LAS float*)(lds + L_LUT);
    for (int i = tid; i < 2 * 8 * 256; i += NWAVES * 64) { const int kind = i >> 11, h = (i >> 8) & 7, rel = (i & 255) - 192; float v;
        if (kind == 0) { const int n = rel < 0 ? -rel : rel; int bk;
            if (n < 8) bk = n; else { const int lg = 31 - __builtin_clz((unsigned)(n * n)); bk = 8 + lg - 6; bk = bk > 15 ? 15 : bk; }
            if (rel > 0) bk += 16;
            v = t5[h * 32 + bk] - t5[h * 32 + 15];
        } else { int ri = rel < -128 ? -128 : rel; ri = ri > 63 ? 63 : ri; v = relb[h * 192 + ri + 128] - relb[h * 192]; }
        lut[i] = v * LOG2E; }
    if (tid < 16) { const unsigned lo = ((tid & 1) ? 0xFFFFu : 0u) | ((tid & 2) ? 0xFFFF0000u : 0u), hi = ((tid & 4) ? 0xFFFFu : 0u) | ((tid & 8) ? 0xFFFF0000u : 0u);
        ((LAS u64*)(lds + L_MLUT))[tid] = (u64)lo | ((u64)hi << 32); }
}

template <bool REF> __device__ __forceinline__ void soft_pack(f32x16& p, bf16x8 (&pa)[2], unsigned wsel, bool has_mask, bool near, int lutidx0, const LAS float* lut, const LAS u64* mlut, int qb, int lane, float ref) {
    const int r32 = lane & 31, hi = lane >> 5;
    if (near) { const LAS float* lp = lut + (lutidx0 - (32 * qb + r32) + 4 * hi);
#pragma unroll
        for (int r4 = 0; r4 < 4; ++r4) { float lv[4];
#pragma unroll
            for (int r = 0; r < 4; ++r) lv[r] = lp[r + 8 * r4];
#pragma unroll
            for (int r = 0; r < 4; ++r) p[4 * r4 + r] += lv[r];
            asm volatile("" ::: "memory"); } }
    if (REF) {
#pragma unroll
        for (int r = 0; r < 16; ++r) p[r] -= ref; }
#pragma unroll
    for (int r = 0; r < 16; ++r) p[r] = __builtin_amdgcn_exp2f(p[r]);
    unsigned pw[8];
#pragma unroll
    for (int j = 0; j < 8; ++j) pw[j] = pg8::cvt_pk_bf16(p[2 * j], p[2 * j + 1]);
    if (has_mask) { const unsigned w = wsel >> (4 * hi);
#pragma unroll
        for (int k = 0; k < 4; ++k) { unsigned nb; asm("v_bfe_u32 %0, %1, %2, 4" : "=v"(nb) : "v"(w), "n"(8 * k)); const u64 mk = mlut[nb]; pw[2 * k] &= (unsigned)mk; pw[2 * k + 1] &= (unsigned)(mk >> 32); } }
    pa[0] = __builtin_bit_cast(bf16x8, (v4u){pw[0], pw[1], pw[2], pw[3]}); pa[1] = __builtin_bit_cast(bf16x8, (v4u){pw[4], pw[5], pw[6], pw[7]});
}
template <bool REF> __device__ __forceinline__ void half_step_fast(f32x16 (&o)[2][2], f32x16 (&L)[2], const bf16x8 (&qr)[2][4], const LAS unsigned char* kb, const LAS unsigned char* vbuf, unsigned w0, unsigned w1,
                                               bool has_mask, bool near, int lutidx0, const LAS float* lut, const LAS u64* mlut, int lane, const float (&ref)[2], const int (&kofs)[4], const int (&vofs)[2]) {
    f32x16 p0, p1;
    { bf16x8 kf[4];
#pragma unroll
      for (int d0 = 0; d0 < 4; ++d0) kf[d0] = *(const LAS bf16x8*)(kb + kofs[d0]);
      f32x16 z;
#pragma unroll
      for (int r = 0; r < 16; ++r) z[r] = 0.f;
      p0 = __builtin_amdgcn_mfma_f32_32x32x16_bf16(kf[0], qr[0][0], z, 0, 0, 0);
#pragma unroll
      for (int d0 = 1; d0 < 4; ++d0) p0 = __builtin_amdgcn_mfma_f32_32x32x16_bf16(kf[d0], qr[0][d0], p0, 0, 0, 0);
      p1 = __builtin_amdgcn_mfma_f32_32x32x16_bf16(kf[0], qr[1][0], z, 0, 0, 0);
#pragma unroll
      for (int d0 = 1; d0 < 4; ++d0) p1 = __builtin_amdgcn_mfma_f32_32x32x16_bf16(kf[d0], qr[1][d0], p1, 0, 0, 0); }
    bf16x8 vf[2][2];
    {
#pragma unroll
      for (int d0 = 0; d0 < 2; ++d0) { const LAS unsigned char* vl_ = vbuf + vofs[d0];
#pragma unroll
        for (int ks = 0; ks < 2; ++ks) {
            const s16x4 vl = __builtin_bit_cast(s16x4, __builtin_amdgcn_ds_read_tr16_b64_v4i16((LAS s16x4*)(vl_ + ks * 2048)));
            const s16x4 vh = __builtin_bit_cast(s16x4, __builtin_amdgcn_ds_read_tr16_b64_v4i16((LAS s16x4*)(vl_ + ks * 2048 + 1024)));
            vf[d0][ks] = (bf16x8){vl[0], vl[1], vl[2], vl[3], vh[0], vh[1], vh[2], vh[3]}; } } }
    bf16x8 pa0[2], pa1[2];
    soft_pack<REF>(p0, pa0, w0, has_mask, near, lutidx0, lut, mlut, 0, lane, ref[0]);
    soft_pack<REF>(p1, pa1, w1, has_mask, near, lutidx0, lut, mlut, 1, lane, ref[1]);
    const bf16x8 ones = __builtin_bit_cast(bf16x8, (v4u){0x3f803f80u, 0x3f803f80u, 0x3f803f80u, 0x3f803f80u});
#pragma unroll
    for (int ks = 0; ks < 2; ++ks) {
#pragma unroll
        for (int d0 = 0; d0 < 2; ++d0) o[0][d0] = __builtin_amdgcn_mfma_f32_32x32x16_bf16(pa0[ks], vf[d0][ks], o[0][d0], 0, 0, 0);
        L[0] = __builtin_amdgcn_mfma_f32_32x32x16_bf16(pa0[ks], ones, L[0], 0, 0, 0);
#pragma unroll
        for (int d0 = 0; d0 < 2; ++d0) o[1][d0] = __builtin_amdgcn_mfma_f32_32x32x16_bf16(pa1[ks], vf[d0][ks], o[1][d0], 0, 0, 0);
        L[1] = __builtin_amdgcn_mfma_f32_32x32x16_bf16(pa1[ks], ones, L[1], 0, 0, 0);
    }
}
template <bool REF> __device__ __forceinline__ void tile_step_fast(f32x16 (&o)[2][2], f32x16 (&L)[2], const bf16x8 (&qr)[2][4], const LAS unsigned char* st, u64 m0, u64 m1, bool has_mask, bool near, int lutidx0,
                                               const LAS float* lut, const LAS u64* mlut, int lane_in0, const float (&ref)[2], const int (&kofs)[4], const int (&vofs)[2]) {
    int lane_in = lane_in0;
#if !defined(FAST_HOIST)
    asm volatile("" : "+v"(lane_in));
#endif
    half_step_fast<REF>(o, L, qr, st, st + 8192, (unsigned)m0, (unsigned)m1, has_mask, near, lutidx0, lut, mlut, lane_in, ref, kofs, vofs);
    half_step_fast<REF>(o, L, qr, st + 4096, st + 8192 + 4096, (unsigned)(m0 >> 32), (unsigned)(m1 >> 32), has_mask, near, lutidx0 + 32, lut, mlut, lane_in, ref, kofs, vofs);
}
__device__ __forceinline__ void tile_step_max(float (&mx)[2], const bf16x8 (&qr)[2][4], const LAS unsigned char* st, u64 m0, u64 m1, bool has_mask, bool near, int lutidx0, const LAS float* lut, int lane_in0) {
    int lane = lane_in0; asm volatile("" : "+v"(lane));
    const int r32 = lane & 31, hi = lane >> 5;
#pragma unroll
    for (int h = 0; h < 2; ++h) {
        const LAS unsigned char* kb = st + h * 4096;
        const int xk = (r32 >> 1) & 3, yk = hi ^ (r32 & 1); const LAS unsigned char* kl = kb + r32 * 128 + yk * 16;
        bf16x8 kf[4];
#pragma unroll
        for (int d0 = 0; d0 < 4; ++d0) kf[d0] = *(const LAS bf16x8*)(kl + ((d0 ^ xk) * 32));
#pragma unroll
        for (int qb = 0; qb < 2; ++qb) {
            f32x16 p;
#pragma unroll
            for (int r = 0; r < 16; ++r) p[r] = 0.f;
#pragma unroll
            for (int d0 = 0; d0 < 4; ++d0) p = __builtin_amdgcn_mfma_f32_32x32x16_bf16(kf[d0], qr[qb][d0], p, 0, 0, 0);
            if (near) { const LAS float* lp = lut + (lutidx0 + 32 * h - (32 * qb + r32) + 4 * hi);
#pragma unroll
                for (int r = 0; r < 16; ++r) p[r] += lp[(r & 3) + 8 * (r >> 2)]; }
            const u64 mm = qb ? m1 : m0; const unsigned w = (unsigned)(h ? (mm >> 32) : mm) >> (4 * hi);
            float tm = mx[qb];
#pragma unroll
            for (int r = 0; r < 16; ++r) { const bool sel = !has_mask || ((w >> ((r & 3) + 8 * (r >> 2))) & 1u); tm = __builtin_fmaxf(tm, sel ? p[r] : -3e38f); }
            mx[qb] = tm;
        }
    }
}
__device__ __forceinline__ void store_o_fast(const f32x16 (&o)[2][2], const f32x16 (&L)[2], bf16* Op, int lane_in) {
    int lane = lane_in; asm volatile("" : "+v"(lane));
    const int r32 = lane & 31, hi = lane >> 5;
#pragma unroll
    for (int qb = 0; qb < 2; ++qb)
#pragma unroll
        for (int r = 0; r < 16; ++r) { const float f = 1.0f / L[qb][r]; bf16* orow = Op + (size_t)(32 * qb + crow(r, hi)) * WA + r32;
            *(GAS bf16*)(orow) = (bf16)f2bf(o[qb][0][r] * f); *(GAS bf16*)(orow + 32) = (bf16)f2bf(o[qb][1][r] * f); }
}
#define QR_OPAQUE() do { _Pragma("unroll") for (int a_ = 0; a_ < 2; ++a_) _Pragma("unroll") for (int b_ = 0; b_ < 4; ++b_) asm volatile("" : "+v"(qr[a_][b_])); } while (0)
constexpr int NSTP = 4, STP_BYTES = 17408;
__device__ __forceinline__ void attn_unit_private(const AUnit& u, int h, const Ptrs& P, LAS unsigned char* lds, int wave, int lane_in) {
    const bool HAS_MASK = (u.kind < 2);
    const LAS float* lut = (const LAS float*)(lds + L_LUT) + ((u.kind >= 2 ? 8 : 0) + h) * 256;
    const LAS u64* mlut = (const LAS u64*)(lds + L_MLUT);
    const int qrow0 = MP + u.b * DSEQ, qc = 16;
    const int t0 = (u.kind == 1) ? 0 : 8, t1 = 16, nt = t1 - t0 + 1;
    const bf16* Qp = ((u.kind < 2) ? P.QA : P.QB) + (size_t)qrow0 * WA + h * 64;
    bf16* Op = ((u.kind < 2) ? P.OA : P.OB) + (size_t)qrow0 * WA + h * 64;
    const u64* mk_base = P.mask + (size_t)idxp::mask_tile_base(1, u.b, 16) * 64;
    bf16x8 qr[2][4];
    { const int r32 = lane_in & 31, hi = lane_in >> 5;
#pragma unroll
    for (int qb = 0; qb < 2; ++qb)
#pragma unroll
        for (int d0 = 0; d0 < 4; ++d0) qr[qb][d0] = *(const GAS bf16x8*)(Qp + (size_t)(32 * qb + r32) * WA + d0 * 16 + hi * 8); }
    f32x16 o[2][2], L[2]; float ref[2] = {0.f, 0.f};
    int kofs[4], vofs[2];
    { const int r32 = lane_in & 31, hi = lane_in >> 5, xk = (r32 >> 1) & 3, yk = hi ^ (r32 & 1);
#pragma unroll
      for (int d0 = 0; d0 < 4; ++d0) { kofs[d0] = r32 * 128 + yk * 16 + ((d0 ^ xk) * 32); asm volatile("" : "+v"(kofs[d0])); }
      const int vq = (lane_in & 15) >> 2, vp = lane_in & 3, vg = (lane_in >> 4) & 1, vx = (lane_in >> 3) & 1;
      const int vb0 = (4 * hi + vq) * 128 + (4 * vx + 2 * vg + (vp >> 1)) * 16 + 8 * (vp & 1);
#pragma unroll
      for (int d0 = 0; d0 < 2; ++d0) { vofs[d0] = vb0 ^ (64 * d0); asm volatile("" : "+v"(vofs[d0])); } }
#define PV_ISSUE(ti) do { const int t_ = t0 + (ti); const bf16 *Kt, *Vt; \
        if (u.kind == 1) { if (t_ < 16) { Kt = P.CKA + (size_t)(u.b * PAST + 64 * t_) * WA; Vt = P.CVA + (size_t)(u.b * PAST + 64 * t_) * WA; } else { Kt = P.KA + (size_t)(MP + u.b * DSEQ) * WA; Vt = P.VA + (size_t)(MP + u.b * DSEQ) * WA; } } \
        else { if (t_ < 16) { Kt = P.CKB + (size_t)(u.b * BANDC + 64 * (t_ - 8)) * WA; Vt = P.CVB + (size_t)(u.b * BANDC + 64 * (t_ - 8)) * WA; } else { Kt = P.KB + (size_t)(MP + u.b * DSEQ) * WA; Vt = P.VB + (size_t)(MP + u.b * DSEQ) * WA; } } \
        int ln_ = lane_in; asm volatile("" : "+v"(ln_)); \
        const unsigned rowoff_ = (unsigned)((ln_ >> 3) * WA + h * 64); \
        const bf16* ks_ = Kt + rowoff_ + (((ln_ & 7) ^ (ln_ >> 3)) * 8); const bf16* vs_ = Vt + rowoff_ + (((ln_ & 7) ^ (4 * ((ln_ >> 4) & 1))) * 8); \
        const unsigned sd_ = (unsigned)__builtin_amdgcn_readfirstlane((int)lds_addr(lds + ((ti) % NSTP) * STP_BYTES)); \
        _Pragma("unroll") for (int i_ = 0; i_ < 8; ++i_) glds16(ks_ + i_ * 8 * WA, sd_ + i_ * 1024); \
        _Pragma("unroll") for (int i_ = 0; i_ < 8; ++i_) glds16(vs_ + i_ * 8 * WA, sd_ + 8192 + i_ * 1024); \
        if (HAS_MASK) glds16(mk_base + (size_t)t_ * 64 + ln_ * 2, sd_ + 16384); \
    } while (0)
#define PV_WALK(INIT, STEP) do { \
    INIT; \
    asm volatile("s_waitcnt vmcnt(0) lgkmcnt(0)" ::: "memory"); \
    QR_OPAQUE(); \
    for (int ti = 0; ti < NSTP - 1 && ti < nt; ++ti) PV_ISSUE(ti); \
    for (int ti = 0; ti < nt; ++ti) { \
        if (ti + NSTP - 2 <= nt - 1) { if (HAS_MASK) asm volatile("s_waitcnt vmcnt(17)" ::: "memory"); else asm volatile("s_waitcnt vmcnt(16)" ::: "memory"); } \
        else asm volatile("s_waitcnt vmcnt(0)" ::: "memory"); \
        asm volatile("s_waitcnt lgkmcnt(0)" ::: "memory");                \
        if (ti + NSTP - 1 < nt) PV_ISSUE(ti + NSTP - 1); \
        const int t = t0 + ti; \
        const LAS unsigned char* st = lds + (ti % NSTP) * STP_BYTES; \
        u64 m0 = ~0ull, m1 = ~0ull; \
        if (HAS_MASK) { int ln = lane_in; asm volatile("" : "+v"(ln)); const LAS u64* ms = (const LAS u64*)(st + 16384); m0 = ms[ln & 31]; m1 = ms[32 + (ln & 31)]; } \
        STEP; \
    } } while (0)
#define PV_ZERO() do { _Pragma("unroll") for (int a_ = 0; a_ < 2; ++a_) _Pragma("unroll") for (int b_ = 0; b_ < 2; ++b_) _Pragma("unroll") for (int r_ = 0; r_ < 16; ++r_) o[a_][b_][r_] = 0.f; \
    _Pragma("unroll") for (int r_ = 0; r_ < 16; ++r_) { L[0][r_] = 0.f; L[1][r_] = 0.f; } } while (0)
    PV_WALK(PV_ZERO(), tile_step_fast<false>(o, L, qr, st, m0, m1, HAS_MASK, t >= qc - 2, 64 * (t - qc + 3), lut, mlut, lane_in, ref, kofs, vofs));
    bool bad;
    { float lmin = L[0][0], lmax = L[0][0];
#pragma unroll
      for (int r = 0; r < 16; ++r) { lmin = __builtin_fminf(lmin, __builtin_fminf(L[0][r], L[1][r])); lmax = __builtin_fmaxf(lmax, __builtin_fmaxf(L[0][r], L[1][r])); }
      bad = !(lmin > 1e-30f && lmax < 1e30f); }
#if defined(ATT_FORCE_REDO)
    bad = true;
#endif
    if (__any(bad)) {
        PV_WALK(ref[0] = -3e38f; ref[1] = -3e38f, tile_step_max(ref, qr, st, m0, m1, HAS_MASK, t >= qc - 2, 64 * (t - qc + 3), lut, lane_in));
        ref[0] = __builtin_fmaxf(ref[0], __shfl_xor(ref[0], 32)); ref[1] = __builtin_fmaxf(ref[1], __shfl_xor(ref[1], 32));
        ref[0] = __builtin_fmaxf(ref[0], -1e30f); ref[1] = __builtin_fmaxf(ref[1], -1e30f);
        PV_WALK(PV_ZERO(), tile_step_fast<true>(o, L, qr, st, m0, m1, HAS_MASK, t >= qc - 2, 64 * (t - qc + 3), lut, mlut, lane_in, ref, kofs, vofs));
    }
#undef PV_ZERO
#undef PV_WALK
#undef PV_ISSUE
    store_o_fast(o, L, Op, lane_in);
    asm volatile("s_waitcnt vmcnt(0) lgkmcnt(0)" ::: "memory");
}

constexpr int NST = 5, ST_BYTES = 24576;
template <bool DSA, int ABL> __device__ __forceinline__ void attn_unit_shared(int b, int h, int g, const Ptrs& P, LAS unsigned char* lds, int wave, int lane_in) {
    constexpr int NP = DSA ? 3 : 2;
    const int c = 8 * g + wave;
    const int tlo = DSA ? 0 : (g > 0 ? 8 * g - 8 : 0), thi = 8 * g + 7, nt = thi - tlo + 1;
    const int wlo = DSA ? 0 : (c > 8 ? c - 8 : 0), whi = c;
    const LAS float* lut = DSA ? (const LAS float*)(lds + L_LUT) + h * 256 : (const LAS float*)(lds + L_BLUT);
    const LAS u64* mlut = (const LAS u64*)(lds + L_MLUT);
    const int qrow0 = b * SEQ + 64 * c;
    const bf16* Qp = (DSA ? P.QA : P.QB) + (size_t)qrow0 * WA + h * 64;
    bf16* Op = (DSA ? P.OA : P.OB) + (size_t)qrow0 * WA + h * 64;
    const bf16* Kh = (DSA ? P.KA : P.KB) + (size_t)b * SEQ * WA + h * 64; const bf16* Vh = (DSA ? P.VA : P.VB) + (size_t)b * SEQ * WA + h * 64;
    const u64* mk_base = P.mask + (size_t)idxp::mask_tile_base(0, b, c) * 64;
    bf16x8 qr[2][4];
    { const int r32 = lane_in & 31, hi = lane_in >> 5;
#pragma unroll
    for (int qb = 0; qb < 2; ++qb)
#pragma unroll
        for (int d0 = 0; d0 < 4; ++d0) qr[qb][d0] = *(const GAS bf16x8*)(Qp + (size_t)(32 * qb + r32) * WA + d0 * 16 + hi * 8); }
    f32x16 o[2][2];
    LAS int* redo = (LAS int*)(lds + L_REDO);
    if (wave == 0 && lane_in == 0) *redo = 0;
#define SH_ISSUE(ti) do { const int t_ = tlo + (ti); int ln_ = lane_in; asm volatile("" : "+v"(ln_)); \
        const unsigned sd_ = (unsigned)__builtin_amdgcn_readfirstlane((int)lds_addr(lds + ((ti) % NST) * ST_BYTES + wave * 1024)); \
        const unsigned ro_ = (unsigned)((64 * t_ + 8 * wave) * WA * 2);       \
        glds16s(dko + ro_, Kh, sd_); \
        glds16s((dko ^ (unsigned)(((ln_ >> 3) ^ (4 * ((ln_ >> 4) & 1))) << 4)) + ro_, Vh, sd_ + 8192);     \
        if (DSA) glds16s((unsigned)(ln_ << 4) + (unsigned)((t_ < c ? t_ : c) * 512), mk_base, sd_ + 16384); \
    } while (0)
#define SH_WALK(INIT, STEP) do { \
    _Pragma("unroll") for (int a_ = 0; a_ < 2; ++a_) _Pragma("unroll") for (int b_ = 0; b_ < 2; ++b_) _Pragma("unroll") for (int r_ = 0; r_ < 16; ++r_) o[a_][b_][r_] = 0.f; \
    INIT; \
    asm volatile("s_waitcnt vmcnt(0)" ::: "memory");                       \
    QR_OPAQUE(); \
    for (int ti = 0; ti < NST - 1 && ti < nt; ++ti) SH_ISSUE(ti); \
    for (int ti = 0; ti < nt; ++ti) { \
        if (ti + NST - 2 <= nt - 1) { if (DSA) asm volatile("s_waitcnt vmcnt(6)" ::: "memory"); else asm volatile("s_waitcnt vmcnt(4)" ::: "memory"); } \
        else asm volatile("s_waitcnt vmcnt(0)" ::: "memory"); \
        asm volatile("s_waitcnt lgkmcnt(0)" ::: "memory");                \
        __builtin_amdgcn_s_barrier(); asm volatile("" ::: "memory"); \
        if (ti + NST - 1 < nt) SH_ISSUE(ti + NST - 1); \
        const int t = tlo + ti; \
        if (t >= wlo && t <= whi) { \
            const LAS unsigned char* st = lds + (ti % NST) * ST_BYTES; \
            u64 m0 = ~0ull, m1 = ~0ull; \
            if (DSA) { int ln = lane_in; asm volatile("" : "+v"(ln)); const LAS u64* ms = (const LAS u64*)(st + 16384 + wave * 1024); m0 = ms[ln & 31]; m1 = ms[32 + (ln & 31)]; } \
            STEP; \
        } \
    } } while (0)
    const int T0 = 8 * g - 8;
#define BD_STAGE(t_) (lds + (((t_) - T0) % NSTB) * STB_BYTES)
#define BD_ISSUE(t_) do { int ln_ = lane_in; asm volatile("" : "+v"(ln_)); \
        const unsigned sd_ = (unsigned)__builtin_amdgcn_readfirstlane((int)lds_addr(BD_STAGE(t_) + wave * 1024)); \
        const unsigned ro_ = (unsigned)((64 * (t_) + 8 * wave) * WA * 2); \
        glds16s(dko + ro_, Kh, sd_); \
        glds16s((dko ^ (unsigned)(((ln_ >> 3) ^ (4 * ((ln_ >> 4) & 1))) << 4)) + ro_, Vh, sd_ + 8192); \
    } while (0)
#define BD_WALK(INIT, STEP) do { \
    _Pragma("unroll") for (int a_ = 0; a_ < 2; ++a_) _Pragma("unroll") for (int b_ = 0; b_ < 2; ++b_) _Pragma("unroll") for (int r_ = 0; r_ < 16; ++r_) o[a_][b_][r_] = 0.f; \
    INIT; \
    asm volatile("s_waitcnt vmcnt(0)" ::: "memory"); \
    QR_OPAQUE(); \
    _Pragma("unroll 1") for (int k_ = 0; k_ < 8; ++k_) if (T0 + k_ >= 0) BD_ISSUE(T0 + k_); \
    asm volatile("s_waitcnt vmcnt(0)" ::: "memory"); \
    __builtin_amdgcn_s_barrier(); asm volatile("" ::: "memory"); \
    _Pragma("unroll 1") for (int i_ = 0; i_ <= 8; ++i_) { \
        if (i_ <= 7) BD_ISSUE(8 * g + i_); \
        const int t = c - 8 + i_; \
        if (t >= 0) { const LAS unsigned char* st = BD_STAGE(t); u64 m0 = ~0ull, m1 = ~0ull; STEP; } \
        asm volatile("s_waitcnt vmcnt(0) lgkmcnt(0)" ::: "memory"); \
        __builtin_amdgcn_s_barrier(); asm volatile("" ::: "memory"); \
    } } while (0)
#define XWALK(INIT, STEP) do { if (DSA) SH_WALK(INIT, STEP); else BD_WALK(INIT, STEP); } while (0)
    f32x16 L[2]; float ref[2] = {0.f, 0.f};
    unsigned dko;
    { const int ln_ = lane_in; dko = (unsigned)(((ln_ >> 3) * WA + (((ln_ & 7) ^ (ln_ >> 3)) * 8)) * 2); asm volatile("" : "+v"(dko)); }
    int kofs[4], vofs[2];
    { const int r32 = lane_in & 31, hi = lane_in >> 5, xk = (r32 >> 1) & 3, yk = hi ^ (r32 & 1);
#pragma unroll
      for (int d0 = 0; d0 < 4; ++d0) { kofs[d0] = r32 * 128 + yk * 16 + ((d0 ^ xk) * 32); asm volatile("" : "+v"(kofs[d0])); }
      const int vq = (lane_in & 15) >> 2, vp = lane_in & 3, vg = (lane_in >> 4) & 1, vx = (lane_in >> 3) & 1;
      const int vb0 = (4 * hi + vq) * 128 + (4 * vx + 2 * vg + (vp >> 1)) * 16 + 8 * (vp & 1);
#pragma unroll
      for (int d0 = 0; d0 < 2; ++d0) { vofs[d0] = vb0 ^ (64 * d0); asm volatile("" : "+v"(vofs[d0])); } }
    XWALK(_Pragma("unroll") for (int r_ = 0; r_ < 16; ++r_) { L[0][r_] = 0.f; L[1][r_] = 0.f; }, tile_step_fast<false>(o, L, qr, st, m0, m1, DSA, t >= c - 2, 64 * (t - c + 3), lut, mlut, lane_in, ref, kofs, vofs));
    { float lmin = L[0][0], lmax = L[0][0];
#pragma unroll
      for (int r = 0; r < 16; ++r) { lmin = __builtin_fminf(lmin, __builtin_fminf(L[0][r], L[1][r])); lmax = __builtin_fmaxf(lmax, __builtin_fmaxf(L[0][r], L[1][r])); }
      const bool bad = !(lmin > 1e-30f && lmax < 1e30f);
      if (__any(bad) && lane_in == 0) *redo = 1; }
    asm volatile("s_waitcnt vmcnt(0) lgkmcnt(0)" ::: "memory");
    __builtin_amdgcn_s_barrier(); asm volatile("" ::: "memory");
    int again = __builtin_amdgcn_readfirstlane(*redo);
#if defined(ATT_FORCE_REDO)
    again = 1;
#endif
    asm volatile("s_waitcnt lgkmcnt(0)" ::: "memory");
    __builtin_amdgcn_s_barrier(); asm volatile("" ::: "memory");
    if (again) {
        XWALK(ref[0] = -3e38f; ref[1] = -3e38f, tile_step_max(ref, qr, st, m0, m1, DSA, t >= c - 2, 64 * (t - c + 3), lut, lane_in));
        ref[0] = __builtin_fmaxf(ref[0], __shfl_xor(ref[0], 32)); ref[1] = __builtin_fmaxf(ref[1], __shfl_xor(ref[1], 32));
        ref[0] = __builtin_fmaxf(ref[0], -1e30f); ref[1] = __builtin_fmaxf(ref[1], -1e30f);
        asm volatile("s_waitcnt vmcnt(0) lgkmcnt(0)" ::: "memory");
        __builtin_amdgcn_s_barrier(); asm volatile("" ::: "memory");
        XWALK(_Pragma("unroll") for (int r_ = 0; r_ < 16; ++r_) { L[0][r_] = 0.f; L[1][r_] = 0.f; }, tile_step_fast<true>(o, L, qr, st, m0, m1, DSA, t >= c - 2, 64 * (t - c + 3), lut, mlut, lane_in, ref, kofs, vofs));
        asm volatile("s_waitcnt vmcnt(0) lgkmcnt(0)" ::: "memory");
        __builtin_amdgcn_s_barrier(); asm volatile("" ::: "memory");
    }
    if (ABL == 0) store_o_fast(o, L, Op, lane_in); else { asm volatile("" :: "v"(o[0][0]), "v"(o[0][1]), "v"(o[1][0]), "v"(o[1][1]), "v"(L[0]), "v"(L[1])); }
#undef XWALK
#undef BD_WALK
#undef BD_ISSUE
#undef BD_STAGE
#undef SH_WALK
#undef SH_ISSUE
    asm volatile("s_waitcnt vmcnt(0) lgkmcnt(0)" ::: "memory");
}

template <int ABL> __device__ __forceinline__ void attn_phase(const Args& A, LAS unsigned char* lds, int vcu, int G, int wave, int lane, int tid) {
    unsigned char* ws = A.ws;
    Ptrs P; P.QA = (const bf16*)(ws + WS_QA); P.KA = (const bf16*)(ws + WS_KA); P.VA = (const bf16*)(ws + WS_VA); P.QB = (const bf16*)(ws + WS_QB); P.KB = (const bf16*)(ws + WS_KB); P.VB = (const bf16*)(ws + WS_VB);
    P.CKA = (const bf16*)(ws + WS_CKA); P.CVA = (const bf16*)(ws + WS_CVA); P.CKB = (const bf16*)(ws + WS_CKB); P.CVB = (const bf16*)(ws + WS_CVB);
    P.OA = (bf16*)(A.out + O_Y); P.OB = (bf16*)(A.out + O_Y) + (size_t)MT * WA;
    P.mask = (const u64*)(ws + WS_MASK);
    build_lut(A.in[7], A.in[15], lds, tid);
    __syncthreads();
    if (wave >= 4) __builtin_amdgcn_s_setprio(1);
    for (int j = vcu; j < 256; j += G) { const int bh = j >> 3, b = bh >> 3, h = bh & 7, g = j & 7;
        if (j != vcu) { __syncthreads(); build_lut(A.in[7], A.in[15], lds, tid); __syncthreads(); }
        if (ABL == 0 && j < 2 * NB_S * 8) {
            __syncthreads();
            if (wave == 0) { const int sj = j & 63; AUnit u{(j < 64) ? 1 : 3, sj >> 3, 16, 0}; attn_unit_private(u, sj & 7, P, lds, wave, lane); }
            __syncthreads(); }
        attn_unit_shared<true, ABL>(b, h, 15 - g, P, lds, wave, lane);
        attn_unit_shared<true, ABL>(b, h, g, P, lds, wave, lane);
        __syncthreads();
        if (tid < 256) ((LAS float*)(lds + L_BLUT))[tid] = ((const LAS float*)(lds + L_LUT))[(8 + h) * 256 + tid];
        __syncthreads();
        attn_unit_shared<false, ABL>(b, h, 15 - g, P, lds, wave, lane);
        attn_unit_shared<false, ABL>(b, h, g, P, lds, wave, lane);
    }
    __builtin_amdgcn_s_setprio(0);
    __syncthreads();
}
}

__device__ __forceinline__ void mix_sample(const Args& A, LAS unsigned char* lds, int bx, int G, int wave, int lane) {
    unsigned char* ws = A.ws;
    const bf16* OA = (const bf16*)(A.out + O_Y); const bf16* OB = OA + (size_t)MT * WA;
    const bf16* WBA = (const bf16*)(ws + WS_WBA); const bf16* WBB = (const bf16*)(ws + WS_WBB);
    bf16* GA = (bf16*)(ws + WS_GA); const bf16* GB = (const bf16*)(ws + WS_GB);
    LAS float* red = (LAS float*)lds;
    const int r32 = lane & 31, hi = lane >> 5;
    for (int u = bx; u < 256; u += G) {
        const int row0 = MP + 32 * (u >> 4), col0 = 64 * (u & 15), k0 = 64 * wave;
        f32x16 acc[2][2];
#pragma unroll
        for (int br = 0; br < 2; ++br)
#pragma unroll
            for (int nb = 0; nb < 2; ++nb)
#pragma unroll
                for (int r = 0; r < 16; ++r) acc[br][nb][r] = 0.f;
#pragma unroll
        for (int br = 0; br < 2; ++br) { const bf16* O = br ? OB : OA; const bf16* W = br ? WBB : WBA;
#pragma unroll
            for (int s = 0; s < 4; ++s) { const bf16x8 a = *(const GAS bf16x8*)(O + (size_t)(row0 + r32) * WA + k0 + 16 * s + 8 * hi);
#pragma unroll
                for (int nb = 0; nb < 2; ++nb) { const bf16x8 b = *(const GAS bf16x8*)(W + (size_t)(col0 + 32 * nb + r32) * WA + k0 + 16 * s + 8 * hi);
                    acc[br][nb] = __builtin_amdgcn_mfma_f32_32x32x16_bf16(a, b, acc[br][nb], 0, 0, 0); } } }
#pragma unroll
        for (int br = 0; br < 2; ++br)
#pragma unroll
            for (int nb = 0; nb < 2; ++nb)
#pragma unroll
                for (int r = 0; r < 16; ++r) red[(wave * 64 + br * 32 + nb * 16 + r) * 64 + lane] = acc[br][nb][r];
        __syncthreads();
#pragma unroll
        for (int i = 0; i < 4; ++i) { const int rho = 4 * wave + i, nb = rho >> 4, r = rho & 15; float sa = 0.f, sb = 0.f;
#pragma unroll
            for (int w = 0; w < 8; ++w) { sa += red[(w * 64 + rho) * 64 + lane]; sb += red[(w * 64 + 32 + rho) * 64 + lane]; }
            const size_t off = (size_t)(row0 + (r & 3) + 8 * (r >> 2) + 4 * hi) * DM + col0 + 32 * nb + r32;
            const float ga = pg8::bf2f(GA[off]), gb = pg8::bf2f(GB[off]);
            GA[off] = (bf16)f2bf(ga * sa + gb * sb); }
        __syncthreads();
    }
}

__global__ void __launch_bounds__(NWAVES * 64, 2) fwd_kernel(Args args0) {
    extern __shared__ __attribute__((aligned(16))) unsigned char lds_raw[];
    LAS unsigned char* lds = (LAS unsigned char*)lds_raw;
    volatile LAS unsigned* MISC = (volatile LAS unsigned*)(lds + MISC_OFF);
    const int tid0 = threadIdx.x, wave = __builtin_amdgcn_readfirstlane(tid0 >> 6);
    const int G = gridDim.x; const int bx = blockIdx.x; const int vcu = (G % 8 == 0) ? (bx % 8) * (G / 8) + bx / 8 : bx;
    unsigned char* ws = args0.ws;
    gu32* ctl = (gu32*)(ws + WS_CTL);
    if (tid0 < 64) MISC[tid0] = 0u;
    __syncthreads();
    XcdBarrier bar; bar.bar = (unsigned*)(ctl + CW_BAR); bar.x = 0; bar.st = nullptr;
    if (N_LAUNCHES == 1) bar = xcd_barrier_post((unsigned*)(ctl + CW_BAR), MISC + 8);
    const int lo = args0.ph_lo, hi = args0.ph_hi;
#ifndef PH_MASK
#define PH_MASK 0xFFFF
#endif
#define IN(k) ((((PH_MASK) >> (k)) & 1) && lo <= (k) && (k) < hi)
#ifndef REP_PHASE
#define REP_PHASE -1
#endif
#define NREP(k) ((k) == REP_PHASE ? 2 : 1)
    constexpr int TAILW = (MT / 256) * (NUP / 256) % 256;
#define SEAM(k) do { if (IN(k) && IN((k) + 1)) xcd_barrier(bar); } while (0)
    const int gw = vcu * NWAVES + wave, NGW = G * NWAVES;
#define PHASE_ARGS int tid = tid0; asm volatile("" : "+v"(tid)); const int lane = tid & 63; (void)lane;   const Args args = load_args(); unsigned char* const ws = args.ws; float* const out = args.out; bf16* const XB = (bf16*)(ws + WS_XB); bf16* const HBIG = (bf16*)(ws + WS_BIG); float* const YS = out + O_Y; (void)XB; (void)HBIG; (void)YS; (void)out

    if (IN(0)) { PHASE_ARGS; for (int rep = 0; rep < NREP(0); ++rep) { p0_prologue(args, lds, 0, vcu, G, wave, lane, tid); if (NREP(0) > 1) __syncthreads(); } }
    SEAM(0);
    if (IN(1)) for (int rep = 0; rep < NREP(1); ++rep) { PHASE_ARGS;
        pg8::Gemm g{XB, (const bf16*)(ws + WS_W1T), MT, NUP, DM}; pg8::StaticOrder S; S.init(MT, NUP, G, bx);
        pg8::EpiSwiglu E{HBIG};
        pg8::gemm_phase<pg8::EpiSwiglu, pg8::StaticOrder, true, true>(lds, g, S, E);
        if (rep == 0) { __syncthreads(); if (G > TAILW) { if (bx >= TAILW) p0_prologue(args, lds, 1, bx - TAILW, G - TAILW, wave, lane, tid); } else p0_prologue(args, lds, 1, bx, G, wave, lane, tid); __syncthreads(); }
    }
    SEAM(1);
    if (IN(2)) for (int rep = 0; rep < NREP(2); ++rep) { PHASE_ARGS;
        { pg8::Gemm g{HBIG, (const bf16*)(ws + WS_W1O), MP, DM, DFF}; pg8::StaticOrder S; S.init(MP, DM, G, bx);
          pg8::EpiResF32<0> E{args.in[0], args.in[1], nullptr, YS, ALPHA, 0.5f};
          pg8::gemm_phase<pg8::EpiResF32<0>, pg8::StaticOrder, true, true>(lds, g, S, E); }
        { pg8::Gemm g{HBIG, (const bf16*)(ws + WS_W1O), MT, DM, 256, DFF}; pg8::SplitOrder S{11, 256, bx};
          pg8::EpiSlab E{(float*)(ws + WS_GB), 256};
          pg8::gemm_phase<pg8::EpiSlab, pg8::SplitOrder, true, true>(lds, g, S, E); }
    }
    SEAM(2);
    if (IN(3)) { PHASE_ARGS; for (int rep = 0; rep < NREP(3); ++rep) { ln_pass<false>(YS, args.in[8], args.in[9], XB, nullptr, gw, NGW, lane, MP);
        ln_pass_sample<false>((const float*)(ws + WS_GB), 11, 0.5f, XB, ALPHA, args.in[8], args.in[9], XB, nullptr, gw, NGW, lane, args.in[1]); } }
    SEAM(3);
    if (IN(4)) for (int rep = 0; rep < NREP(4); ++rep) { PHASE_ARGS;
        pg8::Gemm g{XB, (const bf16*)(ws + WS_WIN), MT, NINP, DM}; pg8::StaticOrder S; S.init(MT, NINP, G, bx);
        pg8::EpiWin E{(bf16*)(ws + WS_QA), (bf16*)(ws + WS_KA), (bf16*)(ws + WS_VA), (bf16*)(ws + WS_QB), (bf16*)(ws + WS_KB), (bf16*)(ws + WS_VB), (bf16*)(ws + WS_GA), (bf16*)(ws + WS_GB),
                      (bf16*)(ws + WS_QI), (bf16*)(ws + WS_KI), (float*)(ws + WS_WX), out};
        pg8::gemm_phase<pg8::EpiWin, pg8::StaticOrder, true, true>(lds, g, S, E);
        if (rep == 0) { __syncthreads(); if (G > TAILW) { if (bx >= TAILW) p0_prologue(args, lds, 2, bx - TAILW, G - TAILW, wave, lane, tid); } else p0_prologue(args, lds, 2, bx, G, wave, lane, tid); __syncthreads(); }
    }
    SEAM(4);
#ifndef IDX_ABL
#define IDX_ABL 0
#endif
    if (IN(5)) { PHASE_ARGS; if (IDX_ABL == 0) { for (int rep = 0; rep < NREP(5); ++rep) idxp::idx_phase<0>(args, lds, vcu, G, wave, lane, tid); } else { idxp::idx_phase<0>(args, lds, vcu, G, wave, lane, tid); if (NREP(5) > 1) idxp::idx_phase<IDX_ABL>(args, lds, vcu, G, wave, lane, tid); } }
    SEAM(5);
#ifndef ATT_ABL
#define ATT_ABL 0
#endif
    if (IN(6)) { PHASE_ARGS; attp::attn_phase<0>(args, lds, vcu, G, wave, lane, tid); if (NREP(6) > 1) attp::attn_phase<ATT_ABL>(args, lds, vcu, G, wave, lane, tid); }
    SEAM(6);
    if (IN(7)) { PHASE_ARGS;
#ifndef P7_PARTS
#define P7_PARTS 3
#endif
        mix_sample(args, lds, bx, G, wave, lane);
        if (P7_PARTS & 1) { pg8::Gemm g{(const bf16*)(out + O_Y), (const bf16*)(ws + WS_WBA), MP, DM, WA}; pg8::StaticOrder S; S.init(MP, DM, G, bx);
          pg8::EpiGate<0> E{(const bf16*)(ws + WS_GA), nullptr, (bf16*)(ws + WS_KA)};
          pg8::gemm_phase<pg8::EpiGate<0>, pg8::StaticOrder, true, true>(lds, g, S, E); }
        if (P7_PARTS & 2) { pg8::Gemm g{(const bf16*)(out + O_Y) + (size_t)MT * WA, (const bf16*)(ws + WS_WBB), MP, DM, WA}; pg8::StaticOrder S; S.init(MP, DM, G, bx);
          pg8::EpiGate<1> E{(const bf16*)(ws + WS_GB), (const bf16*)(ws + WS_KA), (bf16*)(ws + WS_GA)};
          pg8::gemm_phase<pg8::EpiGate<1>, pg8::StaticOrder, true, true>(lds, g, S, E); }
    }
    SEAM(7);
    if (IN(8)) for (int rep = 0; rep < NREP(8); ++rep) { PHASE_ARGS;
        { pg8::Gemm g{(const bf16*)(ws + WS_GA), (const bf16*)(ws + WS_WOUT), MP, DM, DM}; pg8::StaticOrder S; S.init(MP, DM, G, bx);
          pg8::EpiResF32<1> E{nullptr, nullptr, XB, YS, ALPHA, 1.0f};
          pg8::gemm_phase<pg8::EpiResF32<1>, pg8::StaticOrder, true, true>(lds, g, S, E); }
        { pg8::Gemm g{(const bf16*)(ws + WS_GA), (const bf16*)(ws + WS_WOUT), MT, DM, 256, DM}; pg8::SplitOrder S{4, 256, bx};
          pg8::EpiSlab E{(float*)(ws + WS_GB), 256};
          pg8::gemm_phase<pg8::EpiSlab, pg8::SplitOrder, true, true>(lds, g, S, E); }
    }
    SEAM(8);
    if (IN(9)) { PHASE_ARGS; ln_pass<false>(YS, args.in[12], args.in[13], XB, nullptr, gw, NGW, lane, MP); ln_pass_sample<false>((const float*)(ws + WS_GB), 4, 1.0f, XB, ALPHA, args.in[12], args.in[13], XB, nullptr, gw, NGW, lane); }
    SEAM(9);
    if (IN(10)) for (int rep = 0; rep < NREP(10); ++rep) { PHASE_ARGS;
        pg8::Gemm g{XB, (const bf16*)(ws + WS_W2T), MT, NUP, DM}; pg8::StaticOrder S; S.init(MT, NUP, G, bx);
        pg8::EpiSwiglu E{HBIG};
        pg8::gemm_phase<pg8::EpiSwiglu, pg8::StaticOrder, true, true>(lds, g, S, E);
        if (rep == 0) { __syncthreads(); if (G > TAILW) { if (bx >= TAILW) p0_prologue(args, lds, 3, bx - TAILW, G - TAILW, wave, lane, tid); } else p0_prologue(args, lds, 3, bx, G, wave, lane, tid); __syncthreads(); }
    }
    SEAM(10);
    if (IN(11)) for (int rep = 0; rep < NREP(11); ++rep) { PHASE_ARGS;
        { pg8::Gemm g{HBIG, (const bf16*)(ws + WS_W2O), MP, DM, DFF}; pg8::StaticOrder S; S.init(MP, DM, G, bx);
          pg8::EpiResF32<1> E{nullptr, nullptr, XB, YS, ALPHA, 0.5f};
          pg8::gemm_phase<pg8::EpiResF32<1>, pg8::StaticOrder, true, true>(lds, g, S, E); }
        { pg8::Gemm g{HBIG, (const bf16*)(ws + WS_W2O), MT, DM, 256, DFF}; pg8::SplitOrder S{11, 256, bx};
          pg8::EpiSlab E{(float*)(ws + WS_GB), 256};
          pg8::gemm_phase<pg8::EpiSlab, pg8::SplitOrder, true, true>(lds, g, S, E); }
    }
    SEAM(11);
    if (IN(12)) { PHASE_ARGS; ln_pass<true>(YS, args.in[19], args.in[20], nullptr, YS, gw, NGW, lane, MP); ln_pass_sample<true>((const float*)(ws + WS_GB), 11, 0.5f, XB, ALPHA, args.in[19], args.in[20], nullptr, YS, gw, NGW, lane); }

#if defined(DBG_NCAND)
    if (lo <= 12 && 12 < hi) { xcd_barrier(bar); const unsigned* cw = (const unsigned*)(ws + WS_CTL); const float v = (DBG_NCAND == 1) ? sqrtf((float)cw[8]) : sqrtf(1000.0f * (float)cw[9] / (float)cw[10]);
        for (size_t i = (size_t)gw * 64 + lane; i < (size_t)MS * DM; i += (size_t)NGW * 64) YS[(size_t)MP * DM + i] = v; }
#endif
#if defined(DBG_DUMP)
    if (lo <= 12 && 12 < hi) {
        const size_t gt = (size_t)gw * 64 + lane, ngt = (size_t)NGW * 64;
        if (DBG_DUMP == 1) { const unsigned* mw = (const unsigned*)(ws + WS_MASK); for (size_t i = gt; i < (size_t)MASK_TILES * 128; i += ngt) YS[i] = (float)__builtin_popcount(mw[i]) + 0.001f * (float)(mw[i] & 1023u); }
        if (DBG_DUMP == 3) { if (gt < 4096) YS[gt] = (float)(__builtin_amdgcn_s_memrealtime() & 0xFFFFFull); }
        if (DBG_DUMP == 5) { const bf16* mx = (const bf16*)(ws + WS_KA); for (size_t i = gt; i < (size_t)MT * DM; i += ngt) YS[i] = pg8::bf2f(mx[i]); }
        if (DBG_DUMP == 4) { const bf16* mx = (const bf16*)(ws + WS_GA); for (size_t i = gt; i < (size_t)MT * DM; i += ngt) YS[i] = pg8::bf2f(mx[i]); }
        if (DBG_DUMP == 2) { const bf16* oa = (const bf16*)(ws + WS_QA); const bf16* ob = (const bf16*)(ws + WS_QB);
            for (size_t i = gt; i < (size_t)MT * WA; i += ngt) { YS[i] = pg8::bf2f(oa[i]); YS[(size_t)MT * WA + i] = pg8::bf2f(ob[i]); } }
    }
#endif
#undef IN
#undef SEAM
}

extern "C" void kernel_launch(void* const* d_in, const int* in_sizes, int n_in, void* d_out, int out_size, void* d_ws, size_t ws_size, hipStream_t stream) {
    static int grid = 0;
    if (grid == 0) {
        if (n_in != 23 || out_size != (int)O_END || ws_size < WS_END) { fprintf(stderr, "kernel_launch: unexpected shapes: n_in %d out %d ws %zu\n", n_in, out_size, ws_size); grid = -1; return; }
        int dev = 0, cus = 0;
        if (hipGetDevice(&dev) != hipSuccess || hipDeviceGetAttribute(&cus, hipDeviceAttributeMultiprocessorCount, dev) != hipSuccess) { grid = -1; return; }
        if (hipFuncSetAttribute((const void*)fwd_kernel, hipFuncAttributeMaxDynamicSharedMemorySize, LDS_BYTES) != hipSuccess) { fprintf(stderr, "kernel_launch: hipFuncSetAttribute failed\n"); grid = -1; return; }
        int per_cu = 0;
        if (hipOccupancyMaxActiveBlocksPerMultiprocessor(&per_cu, (const void*)fwd_kernel, NWAVES * 64, LDS_BYTES) != hipSuccess || per_cu < 1) fprintf(stderr, "kernel_launch: occupancy query says %d\n", per_cu);
        (void)hipGetLastError();
        grid = cus;
    }
    if (grid < 0) return;
    (void)hipMemsetAsync((char*)d_ws + WS_CTL, 0, CTL_ZERO_BYTES, stream);
    Args a{};
    for (int i = 0; i < 23; ++i) a.in[i] = (const float*)d_in[i];
    a.out = (float*)d_out; a.ws = (unsigned char*)d_ws;
    if (N_LAUNCHES == 1) { a.ph_lo = 0; a.ph_hi = N_PHASES; a.li = 0; hipLaunchKernelGGL(fwd_kernel, dim3(grid), dim3(NWAVES * 64), LDS_BYTES, stream, a); }
    else { for (int li = 0; li < N_PHASES; ++li) { a.ph_lo = li; a.ph_hi = li + 1; a.li = li; hipLaunchKernelGGL(fwd_kernel, dim3(grid), dim3(NWAVES * 64), LDS_BYTES, stream, a); } }
}
```

```cpp
#include <hip/hip_runtime.h>
#include <cstdio>
#include <cstdint>

#ifndef MK_N_LAUNCHES
#define MK_N_LAUNCHES 1
#endif

constexpr int DM = 1024, NB_P = 4, SEQ = 8192, NB_S = 8, DSEQ = 64, PAST = 1024, BANDC = 512;
constexpr int MP = NB_P * SEQ;
constexpr int MS = NB_S * DSEQ;
constexpr int MT = MP + MS;
constexpr int DFF = 2816, NUP = 2 * DFF  , NIN = 5444, NINP = 5632;
constexpr int WA = 512;
constexpr float ALPHA = 1.189207115002721f;
constexpr float LN_EPS = 1e-5f;
constexpr float LOG2E = 1.4426950408889634f;
constexpr float C2 = 0.125f * LOG2E;
constexpr size_t O_Y = 0;
constexpr size_t O_KA_P = (size_t)MT * DM;
constexpr size_t O_VA_P = O_KA_P + (size_t)MP * WA;
constexpr size_t O_KI_P = O_VA_P + (size_t)MP * WA;
constexpr size_t O_KB_P = O_KI_P + (size_t)MP * 64;
constexpr size_t O_VB_P = O_KB_P + (size_t)NB_P * BANDC * WA;
constexpr size_t O_KA_S = O_VB_P + (size_t)NB_P * BANDC * WA;
constexpr size_t O_VA_S = O_KA_S + (size_t)MS * WA;
constexpr size_t O_KI_S = O_VA_S + (size_t)MS * WA;
constexpr size_t O_KB_S = O_KI_S + (size_t)MS * 64;
constexpr size_t O_VB_S = O_KB_S + (size_t)NB_S * BANDC * WA;
constexpr size_t O_END = O_VB_S + (size_t)NB_S * BANDC * WA;
static_assert(O_END == 76578816, "output size");

namespace pg8 {
#define PG8_LAS __attribute__((address_space(3)))
typedef unsigned short bf16_t;
typedef short bf16x8 __attribute__((ext_vector_type(8)));
typedef float f32x4 __attribute__((ext_vector_type(4)));
typedef unsigned u32x4 __attribute__((ext_vector_type(4)));
constexpr int BM = 256, BK = 64, HALF = 128, HTB = HALF * BK * 2  , STAGE_BYTES = 8 * HTB, NXCD = 8, WGM = 8;

__host__ __device__ __forceinline__ int lds_byte(int r, int c) { const int st = (r >> 4) * 2 + (c >> 5), rr = r & 15, cc = c & 31, ob = rr * 64 + cc * 2; return st * 1024 + (ob ^ (((ob >> 9) & 1) << 5)); }
__host__ __device__ __forceinline__ void stage_rc(int b, int& R, int& C) { const int st = b / 1024, sb = b % 1024, swz = sb ^ (((sb >> 9) & 1) << 5); R = (st >> 1) * 16 + swz / 64; C = (st & 1) * 32 + (swz % 64) / 2; }
__host__ __device__ __forceinline__ int perm32(int rho) { const int n = rho >> 4, i = rho & 15; return 8 * (i >> 2) + 4 * n + (i & 3); }

struct Unit { int pm, pn; int ko = 0; };
struct Gemm { const bf16_t* A; const bf16_t* Bt; int M, N, K; int ld = 0; };

struct StaticOrder {
    int nM, nN, nwg, G, c;
    __host__ __device__ void init(int M, int N, int G_, int c_) { nM = M / BM; nN = N / BM; nwg = nM * nN; G = G_; c = c_; }
    __host__ __device__ bool next(int i, Unit& u) const {
        const long L = (long)i * G + c; if (L >= nwg) return false;
        int wgid = (int)L; { const int q = nwg / NXCD, r = nwg % NXCD, xcd = wgid % NXCD, off = wgid / NXCD; wgid = (xcd < r ? xcd * (q + 1) : r * (q + 1) + (xcd - r) * q) + off; }
        const int nig = WGM * nN, gid = wgid / nig, fm = gid * WGM, gsz = (nM - fm) < WGM ? (nM - fm) : WGM;
        u.pm = fm + ((wgid % nig) % gsz); u.pn = (wgid % nig) / gsz; return true;
    }
    __device__ __forceinline__ void a_ready(const Unit&) const {}
    __device__ __forceinline__ void done(const Unit&) const {}
};

typedef float f32x2_cv __attribute__((ext_vector_type(2))); typedef __bf16 bf16x2_cv __attribute__((ext_vector_type(2)));
__device__ __forceinline__ unsigned cvt_pk_bf16(float lo, float hi) { const f32x2_cv v = {lo, hi}; const bf16x2_cv b = __builtin_convertvector(v, bf16x2_cv); return __builtin_bit_cast(unsigned, b); }
typedef float f32x2 __attribute__((ext_vector_type(2)));

typedef unsigned u32x2 __attribute__((ext_vector_type(2)));
__device__ __forceinline__ float bf2f(unsigned short b) { return __uint_as_float((unsigned)b << 16); }
__device__ __forceinline__ float sigmoidf_fast(float x) { return __builtin_amdgcn_rcpf(1.0f + __builtin_amdgcn_exp2f(-x * LOG2E)); }
__device__ __forceinline__ f32x4 unpack_lo(u32x4 w) { return (f32x4){__uint_as_float(w.x << 16), __uint_as_float(w.x & 0xffff0000u), __uint_as_float(w.y << 16), __uint_as_float(w.y & 0xffff0000u)}; }
__device__ __forceinline__ f32x4 unpack_hi(u32x4 w) { return (f32x4){__uint_as_float(w.z << 16), __uint_as_float(w.z & 0xffff0000u), __uint_as_float(w.w << 16), __uint_as_float(w.w & 0xffff0000u)}; }
__device__ __forceinline__ u32x4 pack8(f32x4 v0, f32x4 v1) { u32x4 w; w.x = cvt_pk_bf16(v0[0], v0[1]); w.y = cvt_pk_bf16(v0[2], v0[3]); w.z = cvt_pk_bf16(v1[0], v1[1]); w.w = cvt_pk_bf16(v1[2], v1[3]); return w; }

struct EpiSwiglu {
    static constexpr bool PERM = true, AFTER_DRAIN = false;
    bf16_t* H;
    __device__ __forceinline__ void operator()(const f32x4 (&acc)[2][2][4][2], const Unit& u, int wr, int wc, int fr, int fq) const {
        const int row0 = u.pm * BM + wr * 64 + fr, col0 = u.pn * 128 + wc * 32 + 8 * fq;
#pragma unroll
        for (int ai = 0; ai < 2; ++ai)
#pragma unroll
            for (int m = 0; m < 4; ++m) {
                f32x4 h[2];
#pragma unroll
                for (int n = 0; n < 2; ++n) { const f32x4 a = acc[ai][0][m][n], g = acc[ai][1][m][n];
#pragma unroll
                    for (int j = 0; j < 4; ++j) h[n][j] = a[j] * sigmoidf_fast(a[j]) * g[j]; }
                *(u32x4*)(H + (size_t)(row0 + ai * HALF + m * 16) * DFF + col0) = pack8(h[0], h[1]);
            }
    }
};

template <int RES> struct EpiResF32 {
    static constexpr bool PERM = false, AFTER_DRAIN = false;
    const float* xp; const float* xs; const bf16_t* rb; float* out; float alpha, scale;
    __device__ __forceinline__ void operator()(const f32x4 (&acc)[2][2][4][2], const Unit& u, int wr, int wc, int fr, int fq) const {
        const int row0 = u.pm * BM + wr * 64 + fr, col0 = u.pn * BM + wc * 32 + 4 * fq;
#pragma unroll
        for (int ai = 0; ai < 2; ++ai)
#pragma unroll
            for (int m = 0; m < 4; ++m) { const int row = row0 + ai * HALF + m * 16;
                const float* xr = (row < MP) ? xp + (size_t)row * DM : xs + (size_t)(row - MP) * DM;
#pragma unroll
                for (int bj = 0; bj < 2; ++bj)
#pragma unroll
                    for (int n = 0; n < 2; ++n) { const int c = col0 + bj * HALF + n * 16; f32x4 r;
                        if (RES == 0) r = *(const f32x4*)(xr + c);
                        else { const u32x2 w = *(const u32x2*)(rb + (size_t)row * DM + c); r = (f32x4){__uint_as_float(w.x << 16), __uint_as_float(w.x & 0xffff0000u), __uint_as_float(w.y << 16), __uint_as_float(w.y & 0xffff0000u)}; }
                        *(f32x4*)(out + (size_t)row * DM + c) = r * alpha + acc[ai][bj][m][n] * scale; }
            }
    }
};

template <int ADD> struct EpiGate {
    static constexpr bool PERM = true, AFTER_DRAIN = false;
    const bf16_t* G; const bf16_t* PREV; bf16_t* OUT;
    __device__ __forceinline__ void operator()(const f32x4 (&acc)[2][2][4][2], const Unit& u, int wr, int wc, int fr, int fq) const {
        const int row0 = u.pm * BM + wr * 64 + fr, col0 = u.pn * BM + wc * 32 + 8 * fq;
#pragma unroll
        for (int ai = 0; ai < 2; ++ai)
#pragma unroll
            for (int m = 0; m < 4; ++m)
#pragma unroll
                for (int bj = 0; bj < 2; ++bj) { const size_t off = (size_t)(row0 + ai * HALF + m * 16) * DM + col0 + bj * HALF;
                    const u32x4 g = *(const u32x4*)(G + off);
                    f32x4 v0 = unpack_lo(g) * acc[ai][bj][m][0], v1 = unpack_hi(g) * acc[ai][bj][m][1];
                    if (ADD) { const u32x4 p = *(const u32x4*)(PREV + off); v0 += unpack_lo(p); v1 += unpack_hi(p); }
                    *(u32x4*)(OUT + off) = pack8(v0, v1); }
    }
};

struct EpiWin {
    static constexpr bool PERM = true, AFTER_DRAIN = false;
    bf16_t *QA, *KA, *VA, *QB, *KB, *VB, *GA, *GB, *QI, *KI; float* WX; float* out;
    __device__ __forceinline__ void operator()(const f32x4 (&acc)[2][2][4][2], const Unit& u, int wr, int wc, int fr, int fq) const {
        const int pn = u.pn, row0 = u.pm * BM + wr * 64 + fr, cl = wc * 32 + 8 * fq;
        const bool sample = (u.pm >= MP / BM);
        if (pn < 12) {
            const int grp = pn >> 1;
            bf16_t* dst = grp == 0 ? QA : grp == 1 ? KA : grp == 2 ? VA : grp == 3 ? QB : grp == 4 ? KB : VB;
            const float sc = (grp == 0 || grp == 3) ? C2 : 1.0f;
            const int cb = (pn & 1) * 256 + cl;
            const bool fa = (grp == 1 || grp == 2), fb = (grp == 4 || grp == 5);
            const bool wf = fa || (fb && (sample || (u.pm & 31) >= 30));
            size_t obase = 0;
            if (fa) obase = sample ? (grp == 1 ? O_KA_S : O_VA_S) : (grp == 1 ? O_KA_P : O_VA_P);
            if (fb) obase = sample ? (grp == 4 ? O_KB_S : O_VB_S) : (grp == 4 ? O_KB_P : O_VB_P);
#pragma unroll
            for (int ai = 0; ai < 2; ++ai)
#pragma unroll
                for (int m = 0; m < 4; ++m) { const int row = row0 + ai * HALF + m * 16;
                    size_t orow = 0;
                    if (fa) orow = sample ? (size_t)(row - MP) : (size_t)row;
                    if (fb) { if (sample) { const int s = row - MP; orow = (size_t)((s >> 6) * BANDC + (BANDC - DSEQ) + (s & 63)); } else { orow = (size_t)((row >> 13) * BANDC + ((row & (SEQ - 1)) - (SEQ - BANDC))); } }
#pragma unroll
                    for (int bj = 0; bj < 2; ++bj) { const f32x4 v0 = acc[ai][bj][m][0], v1 = acc[ai][bj][m][1];
                        *(u32x4*)(dst + (size_t)row * WA + cb + bj * HALF) = pack8(v0 * sc, v1 * sc);
                        if (wf) { float* o = out + obase + orow * WA + cb + bj * HALF; *(f32x4*)o = v0; *(f32x4*)(o + 4) = v1; } }
                }
        } else if (pn < 20) {
            bf16_t* dst = pn < 16 ? GA : GB; const int cb = ((pn - 12) & 3) * 256 + cl;
#pragma unroll
            for (int ai = 0; ai < 2; ++ai)
#pragma unroll
                for (int m = 0; m < 4; ++m) { const int row = row0 + ai * HALF + m * 16;
#pragma unroll
                    for (int bj = 0; bj < 2; ++bj) { f32x4 v0 = acc[ai][bj][m][0], v1 = acc[ai][bj][m][1];
#pragma unroll
                        for (int j = 0; j < 4; ++j) { v0[j] = sigmoidf_fast(v0[j]); v1[j] = sigmoidf_fast(v1[j]); }
                        *(u32x4*)(dst + (size_t)row * DM + cb + bj * HALF) = pack8(v0, v1); }
                }
        } else if (pn == 20) {
#pragma unroll
            for (int ai = 0; ai < 2; ++ai)
#pragma unroll
                for (int m = 0; m < 4; ++m) { const int row = row0 + ai * HALF + m * 16;
#pragma unroll
                    for (int bj = 0; bj < 2; ++bj) *(u32x4*)(QI + (size_t)row * 256 + cl + bj * HALF) = pack8(acc[ai][bj][m][0], acc[ai][bj][m][1]); }
        } else {
            const size_t ob = sample ? O_KI_S : O_KI_P;
#pragma unroll
            for (int ai = 0; ai < 2; ++ai)
#pragma unroll
                for (int m = 0; m < 4; ++m) { const int row = row0 + ai * HALF + m * 16; const f32x4 v0 = acc[ai][0][m][0], v1 = acc[ai][0][m][1];
                    if (cl < 64) {
                        *(u32x4*)(KI + (size_t)(row >> 6) * 4096 + (size_t)(((((row >> 4) & 3) * 2 + (cl >> 5)) * 4 + ((cl >> 3) & 3)) * 16 + (row & 15)) * 8) = pack8(v0, v1);
                        float* o = out + ob + (size_t)(sample ? row - MP : row) * 64 + cl; *(f32x4*)o = v0; *(f32x4*)(o + 4) = v1; }
                    else if (cl == 64) *(f32x4*)(WX + (size_t)row * 4) = v0;
                }
        }
    }
};


struct SplitOrder {
    int nsplit, kelems, c;
    __device__ __forceinline__ bool next(int i, Unit& u) const { if (i != 0 || c >= 8 * nsplit) return false; const int ks = c % nsplit, t = c / nsplit; u.pn = t & 3; u.pm = MP / BM + (t >> 2); u.ko = ks * kelems * 2; return true; }
    __device__ __forceinline__ void a_ready(const Unit&) const {}
    __device__ __forceinline__ void done(const Unit&) const {}
};
struct EpiSlab {
    static constexpr bool PERM = false, AFTER_DRAIN = false;
    float* slab; int kelems;
    __device__ __forceinline__ void operator()(const f32x4 (&acc)[2][2][4][2], const Unit& u, int wr, int wc, int fr, int fq) const {
        const int ks = u.ko / (kelems * 2); const int row0 = (u.pm - MP / BM) * BM + wr * 64 + fr, col0 = u.pn * BM + wc * 32 + 4 * fq;
        float* base = slab + (size_t)ks * MS * DM;
#pragma unroll
        for (int ai = 0; ai < 2; ++ai)
#pragma unroll
            for (int m = 0; m < 4; ++m)
#pragma unroll
                for (int bj = 0; bj < 2; ++bj)
#pragma unroll
                    for (int n = 0; n < 2; ++n) *(f32x4*)(base + (size_t)(row0 + ai * HALF + m * 16) * DM + col0 + bj * HALF + n * 16) = acc[ai][bj][m][n];
    }
};
template <class Epi, class Sched, bool ALIGN_EPI = false, bool SP2 = false>
__device__ __forceinline__ void gemm_phase(PG8_LAS unsigned char* lds, const Gemm g, const Sched& S, const Epi& E) {
    const int tid = threadIdx.x, wid = __builtin_amdgcn_readfirstlane(tid >> 6), lane = tid & 63, wr = wid >> 2, wc = wid & 3, fr = lane & 15, fq = lane >> 4;
    const int K = g.K, nt = K / BK, LD = g.ld ? g.ld : g.K;
    unsigned voffA[2], voffB[2];
#pragma unroll
    for (int i = 0; i < 2; ++i) { int R, C; stage_rc(tid * 16 + i * 8192, R, C); const int Rb = Epi::PERM ? ((R & ~31) + perm32(R & 31)) : R;
        voffA[i] = (unsigned)(R * LD + C) * 2u; voffB[i] = (unsigned)(Rb * LD + C) * 2u; }
    const size_t kstep = (size_t)(BK * 2);
    const size_t hstep = (size_t)HALF * LD * 2;
    const size_t tstep = 2 * hstep;
    const unsigned ldsw = (unsigned)wid * 1024u;
    const int aoff = lds_byte(wr * 64 + fr, fq * 8), boff = lds_byte(wc * 32 + fr, fq * 8);
#define PG8_SA(b, h) (((b) * 2 + (h)) * HTB)
#define PG8_SB(b, h) ((4 + (b) * 2 + (h)) * HTB)
#define PG8_STAGE(bufoff, gbase, voff) do { _Pragma("unroll") for (int _i = 0; _i < 2; ++_i) \
        __builtin_amdgcn_global_load_lds((const unsigned*)((const char*)(gbase) + (voff)[_i]), (PG8_LAS unsigned*)(lds + (bufoff) + ldsw + _i * 8192), 16, 0, 0); } while (0)
#define PG8_LDA(dst, b, h) do { _Pragma("unroll") for (int m = 0; m < 4; ++m) _Pragma("unroll") for (int k = 0; k < 2; ++k) dst[m][k] = *(const PG8_LAS bf16x8*)(lds + PG8_SA(b, h) + aoff + m * 2048 + k * 1024); } while (0)
#define PG8_LDB(dst, b, h) do { _Pragma("unroll") for (int n = 0; n < 2; ++n) _Pragma("unroll") for (int k = 0; k < 2; ++k) dst[n][k] = *(const PG8_LAS bf16x8*)(lds + PG8_SB(b, h) + boff + n * 2048 + k * 1024); } while (0)
#define PG8_MMA(ai, bj, At, Bt) do { __builtin_amdgcn_s_setprio(1); _Pragma("unroll") for (int m = 0; m < 4; ++m) _Pragma("unroll") for (int n = 0; n < 2; ++n) _Pragma("unroll") for (int k = 0; k < 2; ++k) \
        acc[ai][bj][m][n] = __builtin_amdgcn_mfma_f32_16x16x32_bf16(Bt[n][k], At[m][k], acc[ai][bj][m][n], 0, 0, 0); __builtin_amdgcn_s_setprio(0); } while (0)
#define PG8_WAIT_V(n) asm volatile("s_waitcnt vmcnt(" #n ")" ::: "memory")
#define PG8_WAIT_L(n) asm volatile("s_waitcnt lgkmcnt(" #n ")" ::: "memory")
#define PG8_BAR __builtin_amdgcn_s_barrier()
#define PG8_SCHED __builtin_amdgcn_sched_barrier(0)
    Unit cur, nxt; int ui = 0;
    if (!S.next(0, cur)) return;
    f32x4 acc[2][2][4][2];
#pragma unroll
    for (int a = 0; a < 2; ++a)
#pragma unroll
        for (int b = 0; b < 2; ++b)
#pragma unroll
            for (int m = 0; m < 4; ++m)
#pragma unroll
                for (int n = 0; n < 2; ++n) acc[a][b][m][n] = (f32x4){0.f, 0.f, 0.f, 0.f};
    bf16x8 At[4][2], B0[2][2], B1[2][2];
    const char* cA = (const char*)g.A + (size_t)cur.pm * tstep + cur.ko; const char* cB = (const char*)g.Bt + (size_t)cur.pn * tstep + cur.ko;
    S.a_ready(cur);
    if constexpr (SP2) {
        PG8_STAGE(PG8_SB(0, 0), cB, voffB); PG8_STAGE(PG8_SB(0, 1), cB + hstep, voffB); PG8_STAGE(PG8_SA(0, 0), cA, voffA); PG8_STAGE(PG8_SA(0, 1), cA + hstep, voffA);
        if (wr == 1) PG8_BAR;
        PG8_WAIT_V(2); PG8_BAR;
        PG8_STAGE(PG8_SB(1, 0), cB + kstep, voffB); PG8_STAGE(PG8_SA(1, 0), cA + kstep, voffA); PG8_STAGE(PG8_SB(1, 1), cB + hstep + kstep, voffB);
        PG8_WAIT_V(6); PG8_BAR;
    } else {
        PG8_STAGE(PG8_SB(0, 0), cB, voffB); PG8_STAGE(PG8_SA(0, 0), cA, voffA); PG8_STAGE(PG8_SB(0, 1), cB + hstep, voffB); PG8_STAGE(PG8_SA(0, 1), cA + hstep, voffA);
        if (wr == 1) PG8_BAR;
        PG8_WAIT_V(4); PG8_BAR;
        PG8_STAGE(PG8_SB(1, 0), cB + kstep, voffB); PG8_STAGE(PG8_SA(1, 0), cA + kstep, voffA); PG8_STAGE(PG8_SB(1, 1), cB + hstep + kstep, voffB);
        PG8_WAIT_V(6); PG8_BAR;
    }
    for (;;) {
        const bool has_next = S.next(ui + 1, nxt);
        const char* nA = has_next ? (const char*)g.A + (size_t)nxt.pm * tstep + nxt.ko : cA; const char* nB = has_next ? (const char*)g.Bt + (size_t)nxt.pn * tstep + nxt.ko : cB;
        for (int t = 0; t < nt; t += 2) {
            const bool last = (t == nt - 2);
            const char* a1 = cA + (size_t)(t + 1) * kstep;
            const char* a2 = last ? nA : cA + (size_t)(t + 2) * kstep; const char* b2 = last ? nB : cB + (size_t)(t + 2) * kstep;
            const char* a3 = a2 + kstep; const char* b3 = b2 + kstep;
            if (last && has_next) S.a_ready(nxt);
            if constexpr (SP2) {
            PG8_LDB(B0, 0, 0); PG8_LDB(B1, 0, 1); PG8_SCHED; PG8_LDA(At, 0, 0); PG8_STAGE(PG8_SA(1, 1), a1 + hstep, voffA);
            PG8_WAIT_V(8); PG8_WAIT_L(0); PG8_BAR; PG8_MMA(0, 0, At, B0); PG8_MMA(0, 1, At, B1); PG8_BAR; PG8_SCHED;
            PG8_LDA(At, 0, 1); PG8_STAGE(PG8_SB(0, 0), b2, voffB); PG8_STAGE(PG8_SB(0, 1), b2 + hstep, voffB); PG8_STAGE(PG8_SA(0, 0), a2, voffA);
            PG8_WAIT_V(8); PG8_WAIT_L(0); PG8_BAR; PG8_MMA(1, 0, At, B0); PG8_MMA(1, 1, At, B1); PG8_BAR; PG8_SCHED;
            PG8_LDB(B0, 1, 0); PG8_LDB(B1, 1, 1); PG8_SCHED; PG8_LDA(At, 1, 0); PG8_STAGE(PG8_SA(0, 1), a2 + hstep, voffA);
            PG8_WAIT_V(8); PG8_WAIT_L(0); PG8_BAR; PG8_MMA(0, 0, At, B0); PG8_MMA(0, 1, At, B1); PG8_BAR; PG8_SCHED;
            PG8_LDA(At, 1, 1); PG8_STAGE(PG8_SB(1, 0), b3, voffB); PG8_STAGE(PG8_SB(1, 1), b3 + hstep, voffB); PG8_STAGE(PG8_SA(1, 0), a3, voffA);
            PG8_WAIT_V(8); PG8_WAIT_L(0); PG8_BAR; PG8_MMA(1, 0, At, B0); PG8_MMA(1, 1, At, B1); PG8_BAR; PG8_SCHED;
            } else {
            PG8_LDB(B0, 0, 0); PG8_SCHED; PG8_LDA(At, 0, 0); PG8_STAGE(PG8_SA(1, 1), a1 + hstep, voffA);
            PG8_WAIT_L(8); PG8_BAR; PG8_WAIT_L(0); PG8_MMA(0, 0, At, B0); PG8_BAR; PG8_SCHED;
            PG8_LDB(B1, 0, 1); PG8_STAGE(PG8_SB(0, 0), b2, voffB);
            PG8_BAR; PG8_WAIT_L(0); PG8_MMA(0, 1, At, B1); PG8_BAR;
            PG8_LDA(At, 0, 1); PG8_STAGE(PG8_SA(0, 0), a2, voffA);
            PG8_BAR; PG8_WAIT_L(0); PG8_MMA(1, 0, At, B0); PG8_BAR; PG8_SCHED;
            PG8_STAGE(PG8_SB(0, 1), b2 + hstep, voffB);
            PG8_WAIT_V(6); PG8_BAR; PG8_MMA(1, 1, At, B1); PG8_BAR;
            PG8_LDB(B0, 1, 0); PG8_SCHED; PG8_LDA(At, 1, 0); PG8_STAGE(PG8_SA(0, 1), a2 + hstep, voffA);
            PG8_WAIT_L(8); PG8_BAR; PG8_WAIT_L(0); PG8_MMA(0, 0, At, B0); PG8_BAR; PG8_SCHED;
            PG8_LDB(B1, 1, 1); PG8_STAGE(PG8_SB(1, 0), b3, voffB);
            PG8_BAR; PG8_WAIT_L(0); PG8_MMA(0, 1, At, B1); PG8_BAR;
            PG8_LDA(At, 1, 1); PG8_STAGE(PG8_SA(1, 0), a3, voffA);
            PG8_BAR; PG8_WAIT_L(0); PG8_MMA(1, 0, At, B0); PG8_BAR; PG8_SCHED;
            PG8_STAGE(PG8_SB(1, 1), b3 + hstep, voffB);
            PG8_WAIT_V(6); PG8_BAR; PG8_MMA(1, 1, At, B1); PG8_BAR;
            }
        }
        if constexpr (ALIGN_EPI) { if (wr == 0) PG8_BAR; }
        if constexpr (!Epi::AFTER_DRAIN) { E(acc, cur, wr, wc, fr, fq); S.done(cur); }
        if (!has_next) break;
#pragma unroll
        for (int a = 0; a < 2; ++a)
#pragma unroll
            for (int b = 0; b < 2; ++b)
#pragma unroll
                for (int m = 0; m < 4; ++m)
#pragma unroll
                    for (int n = 0; n < 2; ++n) acc[a][b][m][n] = (f32x4){0.f, 0.f, 0.f, 0.f};
        cur = nxt; cA = nA; cB = nB; ++ui;
        if constexpr (ALIGN_EPI) { if (wr == 1) PG8_BAR; }
    }
    PG8_WAIT_V(0);
    if constexpr (!ALIGN_EPI) { if (wr == 0) PG8_BAR; }
    PG8_BAR;
    if constexpr (Epi::AFTER_DRAIN) { E.fused(acc, cur, wr, wc, fr, fq, lds, wid, lane); S.done(cur); }
#undef PG8_SA
#undef PG8_SB
#undef PG8_STAGE
#undef PG8_LDA
#undef PG8_LDB
#undef PG8_MMA
#undef PG8_WAIT_V
#undef PG8_WAIT_L
#undef PG8_BAR
#undef PG8_SCHED
}
}
#define GAS __attribute__((address_space(1)))
#define LAS __attribute__((address_space(3)))
typedef unsigned short bf16;
typedef unsigned v4u __attribute__((ext_vector_type(4)));
typedef float f32x4 __attribute__((ext_vector_type(4)));
typedef short bf16x8 __attribute__((ext_vector_type(8)));
typedef GAS unsigned gu32;
typedef GAS unsigned long long gu64;
#define RLX_AGENT __ATOMIC_RELAXED, __HIP_MEMORY_SCOPE_AGENT
#define LDS_WAIT() asm volatile("s_waitcnt lgkmcnt(0)" ::: "memory")
#define VM_WAIT() asm volatile("s_waitcnt vmcnt(0)" ::: "memory")
__device__ __forceinline__ unsigned long long rt() { return __builtin_amdgcn_s_memrealtime(); }
__device__ __forceinline__ unsigned f2bf(float f) { unsigned u = __builtin_bit_cast(unsigned, f); return (u + 0x7fffu + ((u >> 16) & 1u)) >> 16; }
__device__ __forceinline__ unsigned pk2(float lo, float hi) { return f2bf(lo) | (f2bf(hi) << 16); }

#define XB_TMO      128
#define XB_XCNT(j)  (256  + 64 * (j))
#define XB_XSUB(j)  (1280 + 64 * (j))
#define XB_XGEN(j)  (2304 + 64 * (j))
#define XB_TOP      3328
#define XB_TOPGEN   3392
#define XCD_BAR_WORDS 3456
#define XB_SPIN_CAP (1u << 18)

__device__ __forceinline__ unsigned xb_ld(unsigned* p)              { return __hip_atomic_load(p, __ATOMIC_RELAXED, __HIP_MEMORY_SCOPE_AGENT); }
__device__ __forceinline__ unsigned xb_add(unsigned* p, unsigned v) { return __hip_atomic_fetch_add(p, v, __ATOMIC_RELAXED, __HIP_MEMORY_SCOPE_AGENT); }
__device__ __forceinline__ unsigned xb_xcc_id() { return (unsigned)__builtin_amdgcn_s_getreg((3 << 11) | 20) & 0xFu; }
#define XB_SPIN(cond, bar) do { unsigned _sp = 0; while (cond) { __builtin_amdgcn_s_sleep(1); \
    if ((++_sp & 255u) == 0u) { if (xb_ld(&(bar)[XB_TMO])) break; if (_sp > XB_SPIN_CAP) { atomicAdd(&(bar)[XB_TMO], 1u); break; } } } } while (0)

struct XcdBarrier {
    unsigned* bar; unsigned x;
    volatile LAS unsigned* st;
};

__device__ __forceinline__ XcdBarrier xcd_barrier_post(unsigned* bar, volatile LAS unsigned* st) {
    XcdBarrier b; b.bar = bar; b.x = xb_xcc_id(); b.st = st;
    if (threadIdx.x == 0) (void)xb_add(&bar[XB_XCNT(b.x)], 1u);
    return b;
}
__device__ __forceinline__ void xcd_barrier_complete(unsigned* bar, unsigned x, unsigned& nloc, unsigned& nx) {
    const unsigned G = gridDim.x * gridDim.y * gridDim.z;
    unsigned sum, cnt, mine, sp = 0u;
    for (;;) {
        sum = 0u; cnt = 0u; mine = 0u;
#pragma unroll
        for (unsigned j = 0; j < 16; ++j) { const unsigned c = xb_ld(&bar[XB_XCNT(j)]); sum += c; cnt += (c > 0u) ? 1u : 0u; mine = (j == x) ? c : mine; }
        if (sum == G) break;
        __builtin_amdgcn_s_sleep(1);
        if ((++sp & 255u) == 0u) { if (xb_ld(&bar[XB_TMO])) break; if (sp > XB_SPIN_CAP) { atomicAdd(&bar[XB_TMO], 1u); break; } }
    }
    nloc = mine > 0u ? mine : 1u; nx = cnt > 0u ? cnt : 1u;
}

__device__ __forceinline__ void xcd_barrier(const XcdBarrier& b) {
    asm volatile("s_waitcnt vmcnt(0)" ::: "memory");
    __syncthreads();
    if (threadIdx.x == 0) {
        unsigned* bar = b.bar;
        __builtin_amdgcn_s_waitcnt(0);
        unsigned nloc = b.st[0], nx = b.st[1];
        if (nloc == 0u) { xcd_barrier_complete(bar, b.x, nloc, nx); b.st[0] = nloc; b.st[1] = nx; }
        const unsigned old = xb_add(&bar[XB_XSUB(b.x)], 1u);
        const unsigned gen = old / nloc;
        if (old + 1u == (gen + 1u) * nloc) {
            __builtin_amdgcn_fence(__ATOMIC_RELEASE, "agent");
            asm volatile("s_waitcnt vmcnt(0)" ::: "memory");
            const unsigned og = xb_add(&bar[XB_TOP], 1u);
            const unsigned tg = og / nx;
            if (og + 1u == (tg + 1u) * nx) xb_add(&bar[XB_TOPGEN], 1u);
            else XB_SPIN(xb_ld(&bar[XB_TOPGEN]) == tg, bar);
            __builtin_amdgcn_fence(__ATOMIC_ACQUIRE, "agent");
            xb_add(&bar[XB_XGEN(b.x)], 1u);
            asm volatile("s_waitcnt vmcnt(0)" ::: "memory");
        } else {
            XB_SPIN(xb_ld(&bar[XB_XGEN(b.x)]) == gen, bar);
            __builtin_amdgcn_fence(__ATOMIC_ACQUIRE, "agent");
            asm volatile("s_waitcnt vmcnt(0)" ::: "memory");
        }
    }
    __syncthreads();
}

constexpr int NWAVES = 8;
constexpr int N_LAUNCHES = MK_N_LAUNCHES;
constexpr int N_PHASES = 13;
typedef float f32x16 __attribute__((ext_vector_type(16)));
typedef short s16x4 __attribute__((ext_vector_type(4)));
typedef unsigned long long u64;

constexpr size_t MiB = 1u << 20;
constexpr size_t WS_CTL = 0, CTL_ZERO_BYTES = 65536;
constexpr int CW_BAR = 4096;
constexpr size_t WS_W1T = 2 * MiB;
constexpr size_t WS_W1O = 13 * MiB;
constexpr size_t WS_WIN = 19 * MiB;
constexpr size_t WS_WBA = 30 * MiB, WS_WBB = 31 * MiB;
constexpr size_t WS_WOUT = 32 * MiB;
constexpr size_t WS_W2T = 34 * MiB, WS_W2O = 45 * MiB;
constexpr size_t WS_CKA = 51 * MiB, WS_CVA = 59 * MiB;
constexpr size_t WS_CKI = 67 * MiB;
constexpr size_t WS_CKB = 68 * MiB, WS_CVB = 72 * MiB;
constexpr size_t WS_WX = 76 * MiB;
constexpr size_t WS_MASK = 77 * MiB;
constexpr size_t WS_XB = 94 * MiB;
constexpr size_t WS_BIG = 159 * MiB;
constexpr size_t SZ_512 = (size_t)MT * WA * 2;
constexpr size_t WS_QA = WS_BIG, WS_KA = WS_QA + SZ_512, WS_VA = WS_KA + SZ_512, WS_QB = WS_VA + SZ_512, WS_KB = WS_QB + SZ_512, WS_VB = WS_KB + SZ_512;
constexpr size_t WS_GA = WS_VB + SZ_512, WS_GB = WS_GA + (size_t)MT * DM * 2;
constexpr size_t WS_QI = WS_GB + (size_t)MT * DM * 2, WS_KI = WS_QI + (size_t)MT * 256 * 2, WS_END = WS_KI + (size_t)MT * 64 * 2;
static_assert(WS_END <= 512 * MiB, "workspace map");
static_assert(WS_BIG + (size_t)MT * DFF * 2 <= WS_GA, "FFN hidden must not reach the gate/mix region");
constexpr int MASK_TILES_P = NB_P * (128 * 129 / 2);
constexpr int MASK_TILES = MASK_TILES_P + NB_S * 17;
static_assert(WS_MASK + (size_t)MASK_TILES * 512 <= WS_XB, "mask region");

constexpr int LDS_BYTES = 163840;
constexpr int MISC_OFF = 163840 - 256;

struct Args {
    const float* in[23]; float* out; unsigned char* ws; int ph_lo, ph_hi, li, pad;
};
typedef const __attribute__((address_space(4))) Args* KArgsPtr;
__device__ __forceinline__ Args load_args() {
    KArgsPtr kp = (KArgsPtr)__builtin_amdgcn_kernarg_segment_ptr();
    asm volatile("" : "+s"(kp));
    Args a;
#pragma unroll
    for (int i = 0; i < 23; ++i) a.in[i] = kp->in[i];
    a.out = kp->out; a.ws = kp->ws; a.ph_lo = kp->ph_lo; a.ph_hi = kp->ph_hi; a.li = kp->li; a.pad = kp->pad;
    return a;
}

__device__ __forceinline__ float wave_sum(float v) {
#pragma unroll
    for (int o = 1; o < 64; o <<= 1) v += __shfl_xor(v, o);
    return v;
}
__device__ __forceinline__ void tr_item(const float* W, int K, int Nsrc, bf16* WT, int drow0, int scol0, int nvalid, LAS float* scr, int kb, int lane) {
    const int k0 = 64 * kb, j = lane & 31;
    if (nvalid == 32 && ((Nsrc | scol0) & 3) == 0) {
        const int c4 = (lane & 7) * 4, r8 = lane >> 3; f32x4 v[8];
#pragma unroll
        for (int i = 0; i < 8; ++i) v[i] = *(const GAS f32x4*)(W + (size_t)(k0 + 8 * i + r8) * Nsrc + scol0 + c4);
#pragma unroll
        for (int i = 0; i < 8; ++i) { LAS float* d = scr + (8 * i + r8) * 33 + c4; d[0] = v[i].x; d[1] = v[i].y; d[2] = v[i].z; d[3] = v[i].w; }
    } else {
#pragma unroll 8
    for (int i = 0; i < 32; ++i) { const int kk = 2 * i + (lane >> 5); scr[kk * 33 + j] = (j < nvalid) ? W[(size_t)(k0 + kk) * Nsrc + scol0 + j] : 0.f; }
    }
    LDS_WAIT(); asm volatile("" ::: "memory");
    const int c = lane & 7;
#pragma unroll
    for (int jj = 0; jj < 4; ++jj) { const int n = (lane >> 3) + 8 * jj; const LAS float* s = scr + (8 * c) * 33 + n;
        v4u o; o.x = pk2(s[0 * 33], s[1 * 33]); o.y = pk2(s[2 * 33], s[3 * 33]); o.z = pk2(s[4 * 33], s[5 * 33]); o.w = pk2(s[6 * 33], s[7 * 33]);
        *(GAS v4u*)(WT + (size_t)(drow0 + n) * K + k0 + 8 * c) = o; }
    LDS_WAIT(); asm volatile("" ::: "memory");
}
__device__ __forceinline__ int up_src(int g) { const int pn = g >> 3, j0 = (g & 7) * 32; return (j0 < 128) ? 128 * pn + j0 : DFF + 128 * pn + (j0 - 128); }
__device__ __forceinline__ void win_src(int g, int& s0, int& nv) {
    const int d0 = 32 * g; nv = 32;
    if (d0 < 1536) s0 = d0;
    else if (d0 < 3072) s0 = 1860 + (d0 - 1536);
    else if (d0 < 5120) s0 = 3396 + (d0 - 3072);
    else if (d0 < 5376) s0 = 1536 + (d0 - 5120);
    else if (d0 < 5440) s0 = 1792 + (d0 - 5376);
    else if (d0 == 5440) { s0 = 1856; nv = 4; }
    else { s0 = 0; nv = 0; }
}
__device__ __forceinline__ void cvt_flat(const float* src, bf16* dst, size_t n8, size_t gt, size_t ngt) {
    for (size_t i = gt; i < n8; i += ngt) { const f32x4 a = *(const GAS f32x4*)(src + i * 8), b = *(const GAS f32x4*)(src + i * 8 + 4);
        v4u o; o.x = pk2(a.x, a.y); o.y = pk2(a.z, a.w); o.z = pk2(b.x, b.y); o.w = pk2(b.z, b.w); *(GAS v4u*)(dst + i * 8) = o; }
}
__device__ __forceinline__ void cvt_flat_line(const float* src, bf16* dst, size_t n8, size_t gt, size_t ngt) {
    const size_t lane = gt & 63, gwave = gt >> 6, nwaves = ngt >> 6, n4 = n8 * 2, nblk = n4 >> 7;
    size_t wb = gwave;
    for (; wb + nwaves < nblk; wb += 2 * nwaves) { const size_t i0 = (wb << 7) + lane, i1 = ((wb + nwaves) << 7) + lane;
        const f32x4 a = *(const GAS f32x4*)(src + i0 * 4), b = *(const GAS f32x4*)(src + (i0 + 64) * 4), c = *(const GAS f32x4*)(src + i1 * 4), d = *(const GAS f32x4*)(src + (i1 + 64) * 4);
        *(GAS unsigned long long*)(dst + i0 * 4) = (unsigned long long)pk2(a.x, a.y) | ((unsigned long long)pk2(a.z, a.w) << 32);
        *(GAS unsigned long long*)(dst + (i0 + 64) * 4) = (unsigned long long)pk2(b.x, b.y) | ((unsigned long long)pk2(b.z, b.w) << 32);
        *(GAS unsigned long long*)(dst + i1 * 4) = (unsigned long long)pk2(c.x, c.y) | ((unsigned long long)pk2(c.z, c.w) << 32);
        *(GAS unsigned long long*)(dst + (i1 + 64) * 4) = (unsigned long long)pk2(d.x, d.y) | ((unsigned long long)pk2(d.z, d.w) << 32); }
    for (; wb < nblk; wb += nwaves) { const size_t i0 = (wb << 7) + lane;
        const f32x4 a = *(const GAS f32x4*)(src + i0 * 4), b = *(const GAS f32x4*)(src + (i0 + 64) * 4);
        *(GAS unsigned long long*)(dst + i0 * 4) = (unsigned long long)pk2(a.x, a.y) | ((unsigned long long)pk2(a.z, a.w) << 32);
        *(GAS unsigned long long*)(dst + (i0 + 64) * 4) = (unsigned long long)pk2(b.x, b.y) | ((unsigned long long)pk2(b.z, b.w) << 32); }
    for (size_t i = (nblk << 7) + gt; i < n4; i += ngt) { const f32x4 a = *(const GAS f32x4*)(src + i * 4);
        *(GAS unsigned long long*)(dst + i * 4) = (unsigned long long)pk2(a.x, a.y) | ((unsigned long long)pk2(a.z, a.w) << 32); }
}

__device__ __forceinline__ void p0_prologue(const Args& A, LAS unsigned char* lds, int part, int wg, int nwg, int wave, int lane, int tid) {
    const int vcu = wg, G = nwg;
    unsigned char* ws = A.ws;
    LAS float* scr = (LAS float*)(lds + wave * 16384);
    const int gw = vcu * NWAVES + wave, NGW = G * NWAVES;
    const float *ffn1_wi = A.in[10], *ffn1_wo = A.in[11], *w_in = A.in[14], *wba = A.in[16], *wbb = A.in[17], *wout = A.in[18], *ffn2_wi = A.in[21], *ffn2_wo = A.in[22];
    constexpr int I_UP = 16 * 176, I_DN = 44 * 32, I_IN = 16 * 176, I_BR = 8 * 32, I_OUT = 16 * 32;
    constexpr int NITEMS = 2 * I_UP + 2 * I_DN + I_IN + 2 * I_BR + I_OUT;
    for (int it = gw; it < NITEMS; it += NGW) {
        int r = it;
        const int cls = (r < I_UP) ? 0 : (r < 2 * I_UP) ? 2 : (r < 2 * I_UP + I_DN) ? 0 : (r < 2 * I_UP + 2 * I_DN) ? 3 : 1; if (cls != part) continue;
        if (r < I_UP) { const int kb = r / 176, g = r % 176; tr_item(ffn1_wi, DM, NUP, (bf16*)(ws + WS_W1T), 32 * g, up_src(g), 32, scr, kb, lane); continue; } r -= I_UP;
        if (r < I_UP) { const int kb = r / 176, g = r % 176; tr_item(ffn2_wi, DM, NUP, (bf16*)(ws + WS_W2T), 32 * g, up_src(g), 32, scr, kb, lane); continue; } r -= I_UP;
        if (r < I_DN) { const int kb = r / 32, g = r % 32; tr_item(ffn1_wo, DFF, DM, (bf16*)(ws + WS_W1O), 32 * g, 32 * g, 32, scr, kb, lane); continue; } r -= I_DN;
        if (r < I_DN) { const int kb = r / 32, g = r % 32; tr_item(ffn2_wo, DFF, DM, (bf16*)(ws + WS_W2O), 32 * g, 32 * g, 32, scr, kb, lane); continue; } r -= I_DN;
        if (r < I_IN) { const int kb = r / 176, g = r % 176; int s0, nv; win_src(g, s0, nv); tr_item(w_in, DM, NIN, (bf16*)(ws + WS_WIN), 32 * g, s0, nv, scr, kb, lane); continue; } r -= I_IN;
        if (r < I_BR) { const int kb = r / 32, g = r % 32; tr_item(wba, WA, DM, (bf16*)(ws + WS_WBA), 32 * g, 32 * g, 32, scr, kb, lane); continue; } r -= I_BR;
        if (r < I_BR) { const int kb = r / 32, g = r % 32; tr_item(wbb, WA, DM, (bf16*)(ws + WS_WBB), 32 * g, 32 * g, 32, scr, kb, lane); continue; } r -= I_BR;
        { const int kb = r / 32, g = r % 32; tr_item(wout, DM, DM, (bf16*)(ws + WS_WOUT), 32 * g, 32 * g, 32, scr, kb, lane); }
    }
#if defined(DBG_PREFILL)
    { const size_t gt_ = (size_t)(vcu * NWAVES + wave) * 64 + lane, ngt_ = (size_t)G * NWAVES * 64; GAS v4u* gz = (GAS v4u*)(ws + WS_GA); for (size_t i = gt_; i < (size_t)MT * DM * 2 * 2 / 16; i += ngt_) gz[i] = (v4u){0x3F803F80u, 0x3F803F80u, 0x3F803F80u, 0x3F803F80u}; }
#endif
    const size_t gt = (size_t)(vcu * NWAVES + wave) * 64 + lane, ngt = (size_t)G * NWAVES * 64;
    if (part == 0) {
    cvt_flat_line(A.in[0], (bf16*)(ws + WS_XB), (size_t)MP * DM / 8, gt, ngt);
    cvt_flat_line(A.in[1], (bf16*)(ws + WS_XB) + (size_t)MP * DM, (size_t)MS * DM / 8, gt, ngt);
    return; }
    if (part == 3) return;
    if (part == 2) {
    cvt_flat(A.in[2], (bf16*)(ws + WS_CKA), (size_t)NB_S * PAST * WA / 8, gt, ngt);
    cvt_flat(A.in[3], (bf16*)(ws + WS_CVA), (size_t)NB_S * PAST * WA / 8, gt, ngt);
    return; }
    cvt_flat(A.in[4], (bf16*)(ws + WS_CKI), (size_t)NB_S * PAST * 64 / 8, gt, ngt);
    cvt_flat(A.in[5], (bf16*)(ws + WS_CKB), (size_t)NB_S * BANDC * WA / 8, gt, ngt);
    cvt_flat(A.in[6], (bf16*)(ws + WS_CVB), (size_t)NB_S * BANDC * WA / 8, gt, ngt);
    { constexpr size_t PER = (size_t)(BANDC - DSEQ) * WA / 4;
      for (size_t i = gt; i < 2 * NB_S * PER; i += ngt) { const int which = (int)(i / (NB_S * PER)); const size_t r = i % (NB_S * PER); const int b = (int)(r / PER); const size_t e = (r % PER) * 4;
          const float* src = A.in[which ? 6 : 5] + ((size_t)b * BANDC + DSEQ) * WA + e; float* dst = A.out + (which ? O_VB_S : O_KB_S) + (size_t)b * BANDC * WA + e;
          *(GAS f32x4*)dst = *(const GAS f32x4*)src; } }
}

template <bool F32OUT> __device__ __forceinline__ void ln_pass(const float* src, const float* g, const float* b, bf16* dstb, float* dstf, int gw, int NGW, int lane, int mrows = MT) {
    f32x4 gv[4], bv[4];
#pragma unroll
    for (int j = 0; j < 4; ++j) { gv[j] = *((const GAS f32x4*)g + lane + 64 * j); bv[j] = *((const GAS f32x4*)b + lane + 64 * j); }
    for (int m = gw; m < mrows; m += NGW) {
        const GAS f32x4* xr = (const GAS f32x4*)(src + (size_t)m * DM) + lane;
        f32x4 v[4]; float s = 0.f;
#pragma unroll
        for (int j = 0; j < 4; ++j) { v[j] = xr[64 * j]; s += (v[j].x + v[j].y) + (v[j].z + v[j].w); }
        const float mean = wave_sum(s) * (1.f / DM); float s2 = 0.f;
#pragma unroll
        for (int j = 0; j < 4; ++j) { v[j] = v[j] - mean; s2 += (v[j].x * v[j].x + v[j].y * v[j].y) + (v[j].z * v[j].z + v[j].w * v[j].w); }
        const float rstd = 1.f / sqrtf(wave_sum(s2) * (1.f / DM) + LN_EPS);
#pragma unroll
        for (int j = 0; j < 4; ++j) { v[j] = v[j] * rstd * gv[j] + bv[j]; }
        if (F32OUT) { GAS f32x4* o = (GAS f32x4*)(dstf + (size_t)m * DM) + lane;
#pragma unroll
            for (int j = 0; j < 4; ++j) o[64 * j] = v[j];
        } else { GAS unsigned long long* o8 = (GAS unsigned long long*)(dstb + (size_t)m * DM) + lane;
#pragma unroll
            for (int j = 0; j < 4; ++j) o8[64 * j] = (unsigned long long)pk2(v[j].x, v[j].y) | ((unsigned long long)pk2(v[j].z, v[j].w) << 32); }
    }
}

template <bool F32OUT> __device__ __forceinline__ void ln_pass_sample(const float* slab, int nsplit, float scale, const bf16* res, float alpha, const float* g, const float* b, bf16* dstb, float* dstf, int gw, int NGW, int lane, const float* resf = nullptr  ) {
    for (int r = gw; r < MS; r += NGW) { const int m = MP + r;
        f32x4 v[4]; float s = 0.f;
#pragma unroll
        for (int j = 0; j < 4; ++j) { f32x4 a = (f32x4){0.f, 0.f, 0.f, 0.f};
            for (int ks = 0; ks < nsplit; ++ks) a += *((const GAS f32x4*)(slab + ((size_t)ks * MS + r) * DM) + lane + 64 * j);
            f32x4 rr;
            if (resf) rr = *((const GAS f32x4*)(resf + (size_t)r * DM) + lane + 64 * j);
            else { const unsigned long long w = *((const GAS unsigned long long*)(res + (size_t)m * DM) + lane + 64 * j);
                rr = (f32x4){__uint_as_float((unsigned)w << 16), __uint_as_float((unsigned)w & 0xffff0000u), __uint_as_float((unsigned)(w >> 32) << 16), __uint_as_float((unsigned)(w >> 32) & 0xffff0000u)}; }
            v[j] = rr * alpha + a * scale; s += (v[j].x + v[j].y) + (v[j].z + v[j].w); }
        const float mean = wave_sum(s) * (1.f / DM); float s2 = 0.f;
#pragma unroll
        for (int j = 0; j < 4; ++j) { v[j] = v[j] - mean; s2 += (v[j].x * v[j].x + v[j].y * v[j].y) + (v[j].z * v[j].z + v[j].w * v[j].w); }
        const float rstd = 1.f / sqrtf(wave_sum(s2) * (1.f / DM) + LN_EPS);
#pragma unroll
        for (int j = 0; j < 4; ++j) { const f32x4 gv = *((const GAS f32x4*)g + lane + 64 * j), bv = *((const GAS f32x4*)b + lane + 64 * j); v[j] = v[j] * rstd * gv + bv; }
        if (F32OUT) { GAS f32x4* o = (GAS f32x4*)(dstf + (size_t)m * DM) + lane;
#pragma unroll
            for (int j = 0; j < 4; ++j) o[64 * j] = v[j];
        } else { GAS unsigned long long* o8 = (GAS unsigned long long*)(dstb + (size_t)m * DM) + lane;
#pragma unroll
            for (int j = 0; j < 4; ++j) o8[64 * j] = (unsigned long long)pk2(v[j].x, v[j].y) | ((unsigned long long)pk2(v[j].z, v[j].w) << 32); }
    }
}

namespace idxp {
#ifndef IDX_CAP
#define IDX_CAP 160
#endif
constexpr int NBIN = 1024, CAP = IDX_CAP, NSEL = 256;
constexpr int L_HIST = 0;
constexpr int L_LMASK = 65536;
constexpr int L_PSUM = 131072;
constexpr int L_BSTAR = L_PSUM + 2048;
constexpr int L_CABOVE = L_BSTAR + 256;
constexpr int L_NCAND = L_CABOVE + 256;
struct IUnit { int kind, b, c; };

__device__ __forceinline__ float relu_f(float x) { return __builtin_amdgcn_fmed3f(x, 0.f, 3.0e38f); }
__device__ __forceinline__ float mul1(float a, float b) { float r; asm("v_mul_f32 %0, %1, %2" : "=v"(r) : "v"(a), "v"(b)); return r; }
__device__ __forceinline__ float fma1(float a, float b, float c) { float r; asm("v_fma_f32 %0, %1, %2, %3" : "=v"(r) : "v"(a), "v"(b), "v"(c)); return r; }
__device__ __forceinline__ float score4(const f32x4 (&d)[4], int reg, const float (&w)[4]) {
    float r = mul1(w[0], relu_f(d[0][reg]));
    r = fma1(w[1], relu_f(d[1][reg]), r);
    r = fma1(w[2], relu_f(d[2][reg]), r);
    r = fma1(w[3], relu_f(d[3][reg]), r);
    return r;
}
__device__ __forceinline__ int sbin(float s, float invsig, float, int kidx) {
    const float x = mul1(s, invsig);
    const unsigned xb = __float_as_uint(x);
    const int t = (int)((xb >> 18) & 0x1fffu), t2 = (int)((xb >> 19) & 0xfffu);
    int m = (t - 2000) > t2 ? (t - 2000) : t2;
    m = m < 1808 ? 1808 : (m > 2191 ? 2191 : m);
    const int sm = (int)xb >> 31;
    const int bin = (((m - 1808) ^ sm) + 512) + (sm << 7);
    return (x == 0.f) ? (511 - (kidx >> 6)) : bin;
}
__device__ __forceinline__ unsigned skey(float s) { unsigned b = __float_as_uint(s); if ((b << 1) == 0u) b = 0u; return b ^ ((b >> 31) ? 0xFFFFFFFFu : 0x80000000u); }
__device__ __forceinline__ const bf16* ki_tile(const IUnit& u, int t, const bf16* KI, const bf16* CKI) {
    if (u.kind == 0) return KI + (size_t)(u.b * SEQ + 64 * t) * 64;
    return (t < 16) ? CKI + (size_t)(u.b * PAST + 64 * t) * 64 : KI + (size_t)(MP + u.b * DSEQ) * 64;
}
__device__ __forceinline__ int mask_tile_base(int kind, int b, int c) { return kind == 0 ? b * (128 * 129 / 2) + c * (c + 1) / 2 : MASK_TILES_P + b * 17; }

__device__ __forceinline__ unsigned bin_edge_key(int target, float isg) {
    if (target > NBIN - 1) return 0xFF800001u;
    unsigned lo_k = 0u, hi_k = 0xFF800000u;
    for (int it = 0; it < 33; ++it) { if (lo_k >= hi_k) break; const unsigned mid = lo_k + ((hi_k - lo_k) >> 1);
        const unsigned fb = (mid & 0x80000000u) ? (mid ^ 0x80000000u) : ~mid; const float sv = __uint_as_float(fb);
        const int bv = (sv == 0.f) ? 511 : sbin(sv, isg, 0.f, 0);
        if (bv >= target) hi_k = mid; else lo_k = mid + 1u; }
    return lo_k;
}
template <int MODE, int ABL = 0, bool ZR = true> __device__ __forceinline__ void idx_sweep(const IUnit& u, const bf16* KI, const bf16* CKI, const bf16x8 (&Bq)[2][4][2], const float (&wsc)[2][4], const float (&lo_)[2], float inv, int bstar,
                                                            LAS unsigned char* lds, unsigned* maskw, int wave, int lane, float tsel0 = 0.f, float tsel1 = 0.f, float tcand0 = 0.f, float tcand1 = 0.f, int zt0 = -1, int zt1 = -1) {
    const int qh = wave & 1, kq = wave >> 1, nt = u.c + 1;
    float lo[2] = {lo_[0], lo_[1]}, tsel[2] = {tsel0, tsel1}, tcand[2] = {tcand0, tcand1}; int zt[2] = {zt0, zt1};
    asm volatile("" : "+v"(tsel[0]), "+v"(tsel[1]), "+v"(tcand[0]), "+v"(tcand[1]), "+v"(zt[0]), "+v"(zt[1]), "+v"(lo[0]), "+v"(lo[1]));
    LAS unsigned* hist = (LAS unsigned*)(lds + L_HIST); LAS unsigned* candk = (LAS unsigned*)(lds + L_HIST); LAS unsigned short* candi = (LAS unsigned short*)(lds + L_HIST + 64 * CAP * 4); LAS unsigned* ncand = (LAS unsigned*)(lds + L_NCAND);
    bf16x8 An[2];
    unsigned voff = (unsigned)((((16 * kq + (lane & 15)) * 64) + 8 * (lane >> 4)) * 2), voffn = (unsigned)((2 * kq * 64 + lane) * 16); asm volatile("" : "+v"(voff), "+v"(voffn));
#define IDX_FRAG(tt, ks) ((u.kind == 0 || (tt) == 16) ? *(const GAS bf16x8*)((const GAS char*)Kt + voffn + (ks) * 1024) : *(const GAS bf16x8*)((const GAS char*)Kt + voff + (ks) * 64))
    { const bf16* Kt = ki_tile(u, 0, KI, CKI);
#pragma unroll
      for (int ks = 0; ks < 2; ++ks) An[ks] = IDX_FRAG(0, ks); }
    for (int t = 0; t < nt; ++t) {
        int ln_ = lane; asm volatile("" : "+v"(ln_));
        const int l15 = ln_ & 15, lg = ln_ >> 4;
        bf16x8 Ac[2];
#pragma unroll
        for (int ks = 0; ks < 2; ++ks) Ac[ks] = An[ks];
        if (t + 1 < nt) { const bf16* Kt = ki_tile(u, t + 1, KI, CKI);
#pragma unroll
            for (int ks = 0; ks < 2; ++ks) An[ks] = IDX_FRAG(t + 1, ks); }
#pragma unroll
        for (int sq = 0; sq < 2; ++sq) {
            const int qloc = 32 * qh + 16 * sq + l15;
            const bool zs = (zt[sq] >= 0) && (t < zt[sq]), zc = (zt[sq] >= 0) && (t == zt[sq]); const u64 zcm = __builtin_amdgcn_ballot_w64(zc);
            f32x4 d[4];
#pragma unroll
            for (int hh = 0; hh < 4; ++hh) { d[hh] = __builtin_amdgcn_mfma_f32_16x16x32_bf16(Ac[0], Bq[sq][hh][0], (f32x4){0.f, 0.f, 0.f, 0.f}, 0, 0, 0);
                                             d[hh] = __builtin_amdgcn_mfma_f32_16x16x32_bf16(Ac[1], Bq[sq][hh][1], d[hh], 0, 0, 0); }
            unsigned nib = 0u; u64 cmv[4] = {0ull, 0ull, 0ull, 0ull}; float sv[4] = {0.f, 0.f, 0.f, 0.f};
#pragma unroll
            for (int reg = 0; reg < 4; ++reg) {
                const float s = score4(d, reg, wsc[sq]);
                if (MODE == 0) {
                    const float x = mul1(s, lo[sq]); const unsigned xb = __float_as_uint(x);
                    const int tt = (int)((xb >> 18) & 0x1fffu), t2 = (int)((xb >> 19) & 0xfffu);
                    int m = (tt - 2000) > t2 ? (tt - 2000) : t2; m = m < 1808 ? 1808 : (m > 2191 ? 2191 : m);
                    const int w = (x == 0.f) ? (511 - t) : (m - 1808);
                    const unsigned val = (x < 0.f) ? 0x10000u : 1u;
                    if (ABL == 2) { asm volatile("" :: "v"(w), "v"(val)); }
                    else __hip_atomic_fetch_add(hist + qloc * 512 + (w ^ (qloc & 31)), val, __ATOMIC_RELAXED, __HIP_MEMORY_SCOPE_WORKGROUP);
                } else if (MODE == 2) {
                    if (zt[sq] == -2 && s >= tcand[sq] && !(s >= tsel[sq])) __hip_atomic_fetch_add(ncand + 64 + qloc, 1u, __ATOMIC_RELAXED, __HIP_MEMORY_SCOPE_WORKGROUP);
                } else {
                    const bool a = s >= tsel[sq], b = s >= tcand[sq], z = ZR && (s == 0.f);
                    const bool sel = ZR ? (a || (z && zs)) : a;
                    nib |= (sel ? 1u : 0u) << reg;
                    cmv[reg] = ZR ? ((__builtin_amdgcn_ballot_w64(a) ^ __builtin_amdgcn_ballot_w64(b)) | (__builtin_amdgcn_ballot_w64(z) & zcm)) : (__builtin_amdgcn_ballot_w64(a) ^ __builtin_amdgcn_ballot_w64(b));
                    sv[reg] = s;
                }
            }
            if (MODE == 1) {
                if (__builtin_expect((cmv[0] | cmv[1] | cmv[2] | cmv[3]) != 0ull, 0)) {
#pragma unroll
                    for (int reg = 0; reg < 4; ++reg) if (cmv[reg] != 0ull) { if ((cmv[reg] >> ln_) & 1ull) { const unsigned kidx = (unsigned)(64 * t + 16 * kq + 4 * lg + reg);
                        const unsigned pos = __hip_atomic_fetch_add(ncand + qloc, 1u, __ATOMIC_RELAXED, __HIP_MEMORY_SCOPE_WORKGROUP);
                        if (pos < (unsigned)CAP) { candk[qloc * CAP + pos] = skey(sv[reg]); candi[qloc * CAP + pos] = (unsigned short)kidx; } } } } }
            if (MODE == 1) { if (nib) __hip_atomic_fetch_or((LAS unsigned*)(lds + L_LMASK) + (t * 64 + qloc) * 2 + (kq >> 1), nib << (4 * lg + 16 * (kq & 1)), __ATOMIC_RELAXED, __HIP_MEMORY_SCOPE_WORKGROUP); }
        }
    }
}

#undef IDX_FRAG
template <int ABL> __device__ __forceinline__ void idx_unit(const IUnit& u, const bf16* QI, const bf16* KI, const bf16* CKI, const float* WX, unsigned* dbgw, unsigned* maskall, LAS unsigned char* lds, int wave, int lane, int tid) {
    const int nt = u.c + 1, L = 64 * nt;
    unsigned* maskw = maskall + (size_t)mask_tile_base(u.kind, u.b, u.c) * 128;
    if (L <= NSEL) {
        if (ABL == 0) for (int i = tid; i < nt * 128; i += NWAVES * 64) maskw[i] = 0xFFFFFFFFu;
        return;
    }
    const int l15 = lane & 15, lg = lane >> 4, qloc0 = 32 * (wave & 1) + l15;
    const int m0 = (u.kind == 0) ? u.b * SEQ + 64 * u.c : MP + u.b * DSEQ;
    bf16x8 Bq[2][4][2]; float wsc[2][4], lo[2]; const float inv = 0.f;
#pragma unroll
    for (int sq = 0; sq < 2; ++sq) { const int qloc = qloc0 + 16 * sq; float nrm2[4];
#pragma unroll
        for (int hh = 0; hh < 4; ++hh) { float a = 0.f;
#pragma unroll
            for (int ks = 0; ks < 2; ++ks) { Bq[sq][hh][ks] = *(const GAS bf16x8*)(QI + (size_t)(m0 + qloc) * 256 + hh * 64 + ks * 32 + 8 * lg);
#pragma unroll
                for (int j = 0; j < 8; ++j) { const float x = __uint_as_float((unsigned)(unsigned short)Bq[sq][hh][ks][j] << 16); a += x * x; } }
            a += __shfl_xor(a, 16); a += __shfl_xor(a, 32); nrm2[hh] = a;
            wsc[sq][hh] = WX[(size_t)(m0 + qloc) * 4 + hh] * 0.0625f; }
        float sig2 = 0.f;
#pragma unroll
        for (int hh = 0; hh < 4; ++hh) sig2 += wsc[sq][hh] * wsc[sq][hh] * nrm2[hh];
        const float sig = sqrtf(__builtin_fmaxf(sig2, 1e-30f));
        lo[sq] = 1.0f / sig;
        if (lg == 0 && (wave >> 1) == 0) ((LAS float*)(lds + L_NCAND + 2560))[qloc] = lo[sq]; }
    LAS unsigned* hist = (LAS unsigned*)(lds + L_HIST); LAS unsigned* psum = (LAS unsigned*)(lds + L_PSUM);
    LAS int* bst = (LAS int*)(lds + L_BSTAR); LAS int* cab = (LAS int*)(lds + L_CABOVE); LAS unsigned* ncand = (LAS unsigned*)(lds + L_NCAND);
    LAS unsigned* psum2 = (LAS unsigned*)(lds + L_NCAND + 512);
    idx_sweep<0, ABL>(u, KI, CKI, Bq, wsc, lo, inv, 0, lds, maskw, wave, lane);
    __syncthreads();
    if (ABL == 1 || ABL == 2) { LAS v4u* z = (LAS v4u*)(lds + L_HIST); for (int i = tid; i < 131072 / 16; i += NWAVES * 64) z[i] = (v4u){0u, 0u, 0u, 0u}; __syncthreads(); return; }
    const int fq = tid >> 3, fj = tid & 7;
#define HIST_COUNT(B) ({ const int B_ = (B); const int w_ = B_ >= 512 ? B_ - 512 : (B_ >= 384 ? B_ : 383 - B_); const unsigned x_ = hist[fq * 512 + (w_ ^ (fq & 31))]; (int)(B_ >= 384 ? (x_ & 0xffffu) : (x_ >> 16)); })
    { unsigned sacc = 0u;
      if (fj < 7) {
          const int wbase = (fj >= 4) ? 128 * (fj - 4) : (fj == 3 ? 384 : 128 * (2 - fj)); const bool lowh = fj >= 3;
          const LAS v4u* hp = (const LAS v4u*)(hist + fq * 512 + wbase);
          for (int i = 0; i < 32; ++i) { const v4u x = hp[(i + lane) & 31];
              sacc += lowh ? ((x.x & 0xffffu) + (x.y & 0xffffu)) + ((x.z & 0xffffu) + (x.w & 0xffffu)) : ((x.x >> 16) + (x.y >> 16)) + ((x.z >> 16) + (x.w >> 16)); } }
      psum[fq * 8 + fj] = sacc; }
    __syncthreads();
    int P = 0, cumP = 0;
    { int cum = 0; bool hit = false;
      for (int pp = 7; pp >= 0; --pp) { const int sv = (int)psum[fq * 8 + pp]; if (!hit && cum + sv >= NSEL) { P = pp; cumP = cum; hit = true; } if (!hit) cum += sv; } }
    { int sacc = 0;
      for (int i = 0; i < 16; ++i) sacc += HIST_COUNT(128 * P + 16 * fj + i);
      psum2[fq * 8 + fj] = (unsigned)sacc; }
    __syncthreads();
    { int cum = cumP, O = 0; bool hit = false;
      for (int oo = 7; oo >= 0; --oo) { const int sv = (int)psum2[fq * 8 + oo]; if (!hit && cum + sv >= NSEL) { O = oo; hit = true; } if (!hit) cum += sv; }
      int bstar = 0;
      if (fj == O) {
          for (int B = 128 * P + 16 * O + 15; B >= 128 * P + 16 * O; --B) { const int cn = HIST_COUNT(B); if (cum + cn >= NSEL) { bstar = B; break; } cum += cn; }
#undef HIST_COUNT
          bst[fq] = bstar; cab[fq] = cum; ncand[fq] = 0u; }
      bstar = __shfl(bstar, (lane & ~7) | O);
      const bool zreg = (bstar >= 384 && bstar <= 511);
      const unsigned kpos = 0x80000001u;
      if (fj == O) { const float isg = ((LAS float*)(lds + L_NCAND + 2560))[fq];
          const unsigned kc = zreg ? kpos : bin_edge_key(bstar, isg);
          ((LAS float*)(lds + L_NCAND + 2816))[fq] = __uint_as_float((kc & 0x80000000u) ? (kc ^ 0x80000000u) : ~kc);
          ((LAS int*)(lds + L_NCAND + 3328))[fq] = zreg ? (511 - bstar) : -1; }
      if (fj == (O ^ 1)) { const float isg = ((LAS float*)(lds + L_NCAND + 2560))[fq];
          const unsigned ksel = zreg ? kpos : bin_edge_key(bstar + 1, isg);
          ((LAS float*)(lds + L_NCAND + 3072))[fq] = (ksel > 0xFF800000u) ? __builtin_inff() : __uint_as_float((ksel & 0x80000000u) ? (ksel ^ 0x80000000u) : ~ksel); } }
    __syncthreads();
    if (ABL == 4) { __syncthreads(); LAS v4u* z = (LAS v4u*)(lds + L_HIST); for (int i = tid; i < 131072 / 16; i += NWAVES * 64) z[i] = (v4u){0u, 0u, 0u, 0u}; __syncthreads(); return; }
    LAS float* tcs = (LAS float*)(lds + L_NCAND + 2816); LAS float* tss = (LAS float*)(lds + L_NCAND + 3072); LAS int* zts = (LAS int*)(lds + L_NCAND + 3328);
    LAS unsigned* ovfw = (LAS unsigned*)(lds + L_NCAND + 3584);
    for (int round = 0; round < 40; ++round) {
        { LAS v4u* z = (LAS v4u*)(lds + L_LMASK); for (int i = tid; i < 65536 / 16; i += NWAVES * 64) z[i] = (v4u){0u, 0u, 0u, 0u}; }
        if (tid == 0) ovfw[0] = 0u;
        __syncthreads();
        const int bstar = bst[qloc0];
    { const LAS int* ztp = (const LAS int*)(lds + L_NCAND + 3328); const LAS float* tsp = (const LAS float*)(lds + L_NCAND + 3072); const LAS float* tcp = (const LAS float*)(lds + L_NCAND + 2816);
      const int zt0 = ztp[qloc0], zt1 = ztp[qloc0 + 16]; const float ts0 = tsp[qloc0], ts1 = tsp[qloc0 + 16], tc0 = tcp[qloc0], tc1 = tcp[qloc0 + 16];
      if (__builtin_amdgcn_ballot_w64(zt0 >= 0 || zt1 >= 0) != 0ull) idx_sweep<1, 0, true>(u, KI, CKI, Bq, wsc, lo, inv, bstar, lds, maskw, wave, lane, ts0, ts1, tc0, tc1, zt0, zt1);
      else idx_sweep<1, 0, false>(u, KI, CKI, Bq, wsc, lo, inv, bstar, lds, maskw, wave, lane, ts0, ts1, tc0, tc1, zt0, zt1); }
    if (ABL == 3) { __syncthreads(); LAS v4u* z = (LAS v4u*)(lds + L_HIST); for (int i = tid; i < 131072 / 16; i += NWAVES * 64) z[i] = (v4u){0u, 0u, 0u, 0u}; __syncthreads(); return; }
    __syncthreads();
    if (ABL != 5)
    { const int q = tid >> 3, j = tid & 7; LAS unsigned* ck = (LAS unsigned*)(lds + L_HIST) + q * CAP; LAS unsigned short* ci = (LAS unsigned short*)(lds + L_HIST + 64 * CAP * 4) + q * CAP; LAS unsigned* lmask = (LAS unsigned*)(lds + L_LMASK);
#ifdef DBG_NCAND
      if (j == 0) { atomicMax(dbgw + 8, ncand[q]); if (ncand[q] >= (unsigned)CAP) atomicAdd(dbgw + 9, 1u); atomicAdd(dbgw + 10, 1u); }
#endif
      int n = (int)(ncand[q] < (unsigned)CAP ? ncand[q] : (unsigned)CAP); const int need = NSEL - cab[q]; if (ABL == 7) n = n < 8 ? n : 8;
      for (int i = j; i < n; i += 8) { const u64 Ci = ((u64)ck[i] << 13) | (u64)(8191u - ci[i]); int r = 0;
          for (int k = 0; k < n; ++k) r += ((((u64)ck[k] << 13) | (u64)(8191u - ci[k])) > Ci) ? 1 : 0;
          if (r < need) { const unsigned kidx = ci[i]; const int tt = (int)(kidx >> 6), kk = (int)(kidx & 63u);
              __hip_atomic_fetch_or(lmask + (tt * 64 + q) * 2 + (kk >> 5), 1u << (kk & 31), __ATOMIC_RELAXED, __HIP_MEMORY_SCOPE_WORKGROUP); } } }
        __syncthreads();
        if (ABL != 0) break;
        { const int q = tid >> 3, j = tid & 7;
          if (j == 0 && ncand[q] > (unsigned)CAP && zts[q] == -1) { ovfw[0] = 1u; zts[q] = -2; } }
        __syncthreads();
        if (ovfw[0] == 0u) break;
        { const int q = tid >> 3, j = tid & 7;
          if (j == 0) { ncand[64 + q] = 0u;
              if (zts[q] == -2) { const float fc = tcs[q], fs = tss[q]; const unsigned kc = skey(fc), ks = (fs == __builtin_inff()) ? 0xFF800001u : skey(fs);
                  const unsigned km = kc + ((ks - kc) >> 1);
                  ((LAS unsigned*)(lds + L_NCAND + 3840))[q] = km;
                  ((LAS float*)(lds + L_NCAND + 4096))[q] = __uint_as_float((km & 0x80000000u) ? (km ^ 0x80000000u) : ~km); } } }
        __syncthreads();
        idx_sweep<2>(u, KI, CKI, Bq, wsc, lo, inv, 0, lds, maskw, wave, lane, tss[qloc0], tss[qloc0 + 16], ((LAS float*)(lds + L_NCAND + 4096))[qloc0], ((LAS float*)(lds + L_NCAND + 4096))[qloc0 + 16], zts[qloc0], zts[qloc0 + 16]);
        __syncthreads();
        { const int q = tid >> 3, j = tid & 7;
          if (j == 0 && zts[q] == -2) { const int cnt = (int)ncand[64 + q], need = NSEL - cab[q]; const unsigned km = ((LAS unsigned*)(lds + L_NCAND + 3840))[q];
              const float fm = ((LAS float*)(lds + L_NCAND + 4096))[q];
              if (skey(tcs[q]) == km) { zts[q] = -3; }
              else if (cnt >= need) { tcs[q] = fm; zts[q] = -1; }
              else { tss[q] = fm; cab[q] += cnt; zts[q] = -1; } } }
        __syncthreads();
    }
    if (ABL != 6 && ABL != 7) { const LAS v4u* src = (const LAS v4u*)(lds + L_LMASK); GAS v4u* dst = (ABL == 5) ? (GAS v4u*)(maskall + (size_t)MASK_TILES * 128) : (GAS v4u*)maskw; for (int i = tid; i < nt * 32; i += NWAVES * 64) dst[i] = src[i]; }
    __syncthreads();
    { LAS v4u* z = (LAS v4u*)(lds + L_HIST); for (int i = tid; i < 131072 / 16; i += NWAVES * 64) z[i] = (v4u){0u, 0u, 0u, 0u}; }
    __syncthreads();
}

template <int ABL> __device__ __forceinline__ void idx_phase(const Args& A, LAS unsigned char* lds, int vcu, int G, int wave, int lane, int tid) {
    unsigned char* ws = A.ws;
    const bf16 *QI = (const bf16*)(ws + WS_QI), *KI = (const bf16*)(ws + WS_KI), *CKI = (const bf16*)(ws + WS_CKI); const float* WX = (const float*)(ws + WS_WX);
    unsigned* maskall = (unsigned*)(ws + WS_MASK);
    { LAS v4u* z = (LAS v4u*)(lds + L_HIST); for (int i = tid; i < 131072 / 16; i += NWAVES * 64) z[i] = (v4u){0u, 0u, 0u, 0u}; }
    __syncthreads();
    for (int j = vcu; j < 256; j += G) { const int b = j >> 6, i = j & 63;
        int cbig = 127 - i, samp = -1;
        if (i >= 10 && i <= 28) cbig = 128 - i; else if (i == 9) { cbig = 99; samp = 2 * b; }
        else if (i >= 33 && i <= 51) cbig = 128 - i; else if (i == 32) { cbig = 76; samp = 2 * b + 1; }
        IUnit u{0, b, cbig}; idx_unit<ABL>(u, QI, KI, CKI, WX, (unsigned*)(ws + WS_CTL), maskall, lds, wave, lane, tid);
        IUnit v{0, b, i}; idx_unit<ABL>(v, QI, KI, CKI, WX, (unsigned*)(ws + WS_CTL), maskall, lds, wave, lane, tid);
        if (samp >= 0) { IUnit w{1, samp, 16}; idx_unit<ABL>(w, QI, KI, CKI, WX, (unsigned*)(ws + WS_CTL), maskall, lds, wave, lane, tid); } }
}
}

namespace attp {
constexpr int L_SCR = 131072;
constexpr int L_LUT = L_SCR + 4096;
constexpr int L_REDO = L_LUT + 16384;
constexpr int L_MLUT = L_REDO + 128;
typedef __bf16 bf16v2 __attribute__((ext_vector_type(2)));
struct AUnit { int kind, b, c, desc; };
struct Ptrs { const bf16 *QA, *KA, *VA, *QB, *KB, *VB, *CKA, *CVA, *CKB, *CVB; bf16 *OA, *OB; const u64* mask; };
__device__ __forceinline__ int crow(int r, int hi) { return (r & 3) + 8 * (r >> 2) + 4 * hi; }
__device__ __forceinline__ void glds16(const void* gsrc, unsigned lds_dst) { unsigned keep;
    asm volatile("s_mov_b32 %0, m0\n\ts_mov_b32 m0, %2\n\ts_nop 0\n\tglobal_load_lds_dwordx4 %1, off\n\ts_mov_b32 m0, %0" : "=&s"(keep) : "v"(gsrc), "s"(lds_dst) : "memory"); }
__device__ __forceinline__ void glds16s(unsigned voff, const void* sbase, unsigned lds_dst) { unsigned keep;
    asm volatile("s_mov_b32 %0, m0\n\ts_mov_b32 m0, %3\n\ts_nop 0\n\tglobal_load_lds_dwordx4 %1, %2\n\ts_mov_b32 m0, %0" : "=&s"(keep) : "v"(voff), "s"(sbase), "s"(lds_dst) : "memory"); }
__device__ __forceinline__ unsigned lds_addr(const LAS void* p) { return (unsigned)(uintptr_t)p; }

__device__ __forceinline__ void build_lut(const float* t5, const float* relb, LAS unsigned char* lds, int tid) {
    LAS float* lut = (LAS float*)(lds + L_LUT);
    for (int i = tid; i < 2 * 8 * 256; i += NWAVES * 64) { const int kind = i >> 11, h = (i >> 8) & 7, rel = (i & 255) - 192; float v;
        if (kind == 0) { const int n = rel < 0 ? -rel : rel; int bk;
            if (n < 8) bk = n; else { const int lg = 31 - __builtin_clz((unsigned)(n * n)); bk = 8 + lg - 6; bk = bk > 15 ? 15 : bk; }
            if (rel > 0) bk += 16;
            v = t5[h * 32 + bk] - t5[h * 32 + 15];
        } else { int ri = rel < -128 ? -128 : rel; ri = ri > 63 ? 63 : ri; v = relb[h * 192 + ri + 128] - relb[h * 192]; }
        lut[i] = v * LOG2E; }
    if (tid < 16) { const unsigned lo = ((tid & 1) ? 0xFFFFu : 0u) | ((tid & 2) ? 0xFFFF0000u : 0u), hi = ((tid & 4) ? 0xFFFFu : 0u) | ((tid & 8) ? 0xFFFF0000u : 0u);
        ((LAS u64*)(lds + L_MLUT))[tid] = (u64)lo | ((u64)hi << 32); }
}

template <bool REF> __device__ __forceinline__ void soft_pack(f32x16& p, bf16x8 (&pa)[2], unsigned wsel, bool has_mask, bool near, int lutidx0, const LAS float* lut, const LAS u64* mlut, int qb, int lane, float ref) {
    const int r32 = lane & 31, hi = lane >> 5;
    if (near) { const LAS float* lp = lut + (lutidx0 - (32 * qb + r32) + 4 * hi);
#pragma unroll
        for (int r4 = 0; r4 < 4; ++r4) { float lv[4];
#pragma unroll
            for (int r = 0; r < 4; ++r) lv[r] = lp[r + 8 * r4];
#pragma unroll
            for (int r = 0; r < 4; ++r) p[4 * r4 + r] += lv[r];
            asm volatile("" ::: "memory"); } }
    if (REF) {
#pragma unroll
        for (int r = 0; r < 16; ++r) p[r] -= ref; }
#pragma unroll
    for (int r = 0; r < 16; ++r) p[r] = __builtin_amdgcn_exp2f(p[r]);
    unsigned pw[8];
#pragma unroll
    for (int j = 0; j < 8; ++j) pw[j] = pg8::cvt_pk_bf16(p[2 * j], p[2 * j + 1]);
    if (has_mask) { const unsigned w = wsel >> (4 * hi);
#pragma unroll
        for (int k = 0; k < 4; ++k) { unsigned nb; asm("v_bfe_u32 %0, %1, %2, 4" : "=v"(nb) : "v"(w), "n"(8 * k)); const u64 mk = mlut[nb]; pw[2 * k] &= (unsigned)mk; pw[2 * k + 1] &= (unsigned)(mk >> 32); } }
    pa[0] = __builtin_bit_cast(bf16x8, (v4u){pw[0], pw[1], pw[2], pw[3]}); pa[1] = __builtin_bit_cast(bf16x8, (v4u){pw[4], pw[5], pw[6], pw[7]});
}
template <bool REF> __device__ __forceinline__ void half_step_fast(f32x16 (&o)[2][2], f32x16 (&L)[2], const bf16x8 (&qr)[2][4], const LAS unsigned char* kb, const LAS unsigned char* vbuf, unsigned w0, unsigned w1,
                                               bool has_mask, bool near, int lutidx0, const LAS float* lut, const LAS u64* mlut, int lane, const float (&ref)[2], const int (&kofs)[4], const int (&vofs)[2]) {
    f32x16 p0, p1;
    { bf16x8 kf[4];
#pragma unroll
      for (int d0 = 0; d0 < 4; ++d0) kf[d0] = *(const LAS bf16x8*)(kb + kofs[d0]);
      f32x16 z;
#pragma unroll
      for (int r = 0; r < 16; ++r) z[r] = 0.f;
      p0 = __builtin_amdgcn_mfma_f32_32x32x16_bf16(kf[0], qr[0][0], z, 0, 0, 0);
#pragma unroll
      for (int d0 = 1; d0 < 4; ++d0) p0 = __builtin_amdgcn_mfma_f32_32x32x16_bf16(kf[d0], qr[0][d0], p0, 0, 0, 0);
      p1 = __builtin_amdgcn_mfma_f32_32x32x16_bf16(kf[0], qr[1][0], z, 0, 0, 0);
#pragma unroll
      for (int d0 = 1; d0 < 4; ++d0) p1 = __builtin_amdgcn_mfma_f32_32x32x16_bf16(kf[d0], qr[1][d0], p1, 0, 0, 0); }
    bf16x8 vf[2][2];
    {
#pragma unroll
      for (int d0 = 0; d0 < 2; ++d0) { const LAS unsigned char* vl_ = vbuf + vofs[d0];
#pragma unroll
        for (int ks = 0; ks < 2; ++ks) {
            const s16x4 vl = __builtin_bit_cast(s16x4, __builtin_amdgcn_ds_read_tr16_b64_v4i16((LAS s16x4*)(vl_ + ks * 2048)));
            const s16x4 vh = __builtin_bit_cast(s16x4, __builtin_amdgcn_ds_read_tr16_b64_v4i16((LAS s16x4*)(vl_ + ks * 2048 + 1024)));
            vf[d0][ks] = (bf16x8){vl[0], vl[1], vl[2], vl[3], vh[0], vh[1], vh[2], vh[3]}; } } }
    bf16x8 pa0[2], pa1[2];
    soft_pack<REF>(p0, pa0, w0, has_mask, near, lutidx0, lut, mlut, 0, lane, ref[0]);
    soft_pack<REF>(p1, pa1, w1, has_mask, near, lutidx0, lut, mlut, 1, lane, ref[1]);
    const bf16x8 ones = __builtin_bit_cast(bf16x8, (v4u){0x3f803f80u, 0x3f803f80u, 0x3f803f80u, 0x3f803f80u});
#pragma unroll
    for (int ks = 0; ks < 2; ++ks) {
#pragma unroll
        for (int d0 = 0; d0 < 2; ++d0) o[0][d0] = __builtin_amdgcn_mfma_f32_32x32x16_bf16(pa0[ks], vf[d0][ks], o[0][d0], 0, 0, 0);
        L[0] = __builtin_amdgcn_mfma_f32_32x32x16_bf16(pa0[ks], ones, L[0], 0, 0, 0);
#pragma unroll
        for (int d0 = 0; d0 < 2; ++d0) o[1][d0] = __builtin_amdgcn_mfma_f32_32x32x16_bf16(pa1[ks], vf[d0][ks], o[1][d0], 0, 0, 0);
        L[1] = __builtin_amdgcn_mfma_f32_32x32x16_bf16(pa1[ks], ones, L[1], 0, 0, 0);
    }
}
template <bool REF> __device__ __forceinline__ void tile_step_fast(f32x16 (&o)[2][2], f32x16 (&L)[2], const bf16x8 (&qr)[2][4], const LAS unsigned char* st, u64 m0, u64 m1, bool has_mask, bool near, int lutidx0,
                                               const LAS float* lut, const LAS u64* mlut, int lane_in0, const float (&ref)[2], const int (&kofs)[4], const int (&vofs)[2]) {
    int lane_in = lane_in0;
#if !defined(FAST_HOIST)
    asm volatile("" : "+v"(lane_in));
#endif
    half_step_fast<REF>(o, L, qr, st, st + 8192, (unsigned)m0, (unsigned)m1, has_mask, near, lutidx0, lut, mlut, lane_in, ref, kofs, vofs);
    half_step_fast<REF>(o, L, qr, st + 4096, st + 8192 + 4096, (unsigned)(m0 >> 32), (unsigned)(m1 >> 32), has_mask, near, lutidx0 + 32, lut, mlut, lane_in, ref, kofs, vofs);
}
__device__ __forceinline__ void tile_step_max(float (&mx)[2], const bf16x8 (&qr)[2][4], const LAS unsigned char* st, u64 m0, u64 m1, bool has_mask, bool near, int lutidx0, const LAS float* lut, int lane_in0) {
    int lane = lane_in0; asm volatile("" : "+v"(lane));
    const int r32 = lane & 31, hi = lane >> 5;
#pragma unroll
    for (int h = 0; h < 2; ++h) {
        const LAS unsigned char* kb = st + h * 4096;
        const int xk = (r32 >> 1) & 3, yk = hi ^ (r32 & 1); const LAS unsigned char* kl = kb + r32 * 128 + yk * 16;
        bf16x8 kf[4];
#pragma unroll
        for (int d0 = 0; d0 < 4; ++d0) kf[d0] = *(const LAS bf16x8*)(kl + ((d0 ^ xk) * 32));
#pragma unroll
        for (int qb = 0; qb < 2; ++qb) {
            f32x16 p;
#pragma unroll
            for (int r = 0; r < 16; ++r) p[r] = 0.f;
#pragma unroll
            for (int d0 = 0; d0 < 4; ++d0) p = __builtin_amdgcn_mfma_f32_32x32x16_bf16(kf[d0], qr[qb][d0], p, 0, 0, 0);
            if (near) { const LAS float* lp = lut + (lutidx0 + 32 * h - (32 * qb + r32) + 4 * hi);
#pragma unroll
                for (int r = 0; r < 16; ++r) p[r] += lp[(r & 3) + 8 * (r >> 2)]; }
            const u64 mm = qb ? m1 : m0; const unsigned w = (unsigned)(h ? (mm >> 32) : mm) >> (4 * hi);
            float tm = mx[qb];
#pragma unroll
            for (int r = 0; r < 16; ++r) { const bool sel = !has_mask || ((w >> ((r & 3) + 8 * (r >> 2))) & 1u); tm = __builtin_fmaxf(tm, sel ? p[r] : -3e38f); }
            mx[qb] = tm;
        }
    }
}
__device__ __forceinline__ void store_o_fast(const f32x16 (&o)[2][2], const f32x16 (&L)[2], bf16* Op, int lane_in) {
    int lane = lane_in; asm volatile("" : "+v"(lane));
    const int r32 = lane & 31, hi = lane >> 5;
#pragma unroll
    for (int qb = 0; qb < 2; ++qb)
#pragma unroll
        for (int r = 0; r < 16; ++r) { const float f = 1.0f / L[qb][r]; bf16* orow = Op + (size_t)(32 * qb + crow(r, hi)) * WA + r32;
            *(GAS bf16*)(orow) = (bf16)f2bf(o[qb][0][r] * f); *(GAS bf16*)(orow + 32) = (bf16)f2bf(o[qb][1][r] * f); }
}
#define QR_OPAQUE() do { _Pragma("unroll") for (int a_ = 0; a_ < 2; ++a_) _Pragma("unroll") for (int b_ = 0; b_ < 4; ++b_) asm volatile("" : "+v"(qr[a_][b_])); } while (0)
constexpr int NSTP = 4, STP_BYTES = 17408;
__device__ __forceinline__ void attn_unit_private(const AUnit& u, int h, const Ptrs& P, LAS unsigned char* lds, int wave, int lane_in) {
    const bool HAS_MASK = (u.kind < 2);
    const LAS float* lut = (const LAS float*)(lds + L_LUT) + ((u.kind >= 2 ? 8 : 0) + h) * 256;
    const LAS u64* mlut = (const LAS u64*)(lds + L_MLUT);
    const int qrow0 = MP + u.b * DSEQ, qc = 16;
    const int t0 = (u.kind == 1) ? 0 : 8, t1 = 16, nt = t1 - t0 + 1;
    const bf16* Qp = ((u.kind < 2) ? P.QA : P.QB) + (size_t)qrow0 * WA + h * 64;
    bf16* Op = ((u.kind < 2) ? P.OA : P.OB) + (size_t)qrow0 * WA + h * 64;
    const u64* mk_base = P.mask + (size_t)idxp::mask_tile_base(1, u.b, 16) * 64;
    bf16x8 qr[2][4];
    { const int r32 = lane_in & 31, hi = lane_in >> 5;
#pragma unroll
    for (int qb = 0; qb < 2; ++qb)
#pragma unroll
        for (int d0 = 0; d0 < 4; ++d0) qr[qb][d0] = *(const GAS bf16x8*)(Qp + (size_t)(32 * qb + r32) * WA + d0 * 16 + hi * 8); }
    f32x16 o[2][2], L[2]; float ref[2] = {0.f, 0.f};
    int kofs[4], vofs[2];
    { const int r32 = lane_in & 31, hi = lane_in >> 5, xk = (r32 >> 1) & 3, yk = hi ^ (r32 & 1);
#pragma unroll
      for (int d0 = 0; d0 < 4; ++d0) { kofs[d0] = r32 * 128 + yk * 16 + ((d0 ^ xk) * 32); asm volatile("" : "+v"(kofs[d0])); }
      const int vq = (lane_in & 15) >> 2, vp = lane_in & 3, vg = (lane_in >> 4) & 1, vx = (lane_in >> 3) & 1;
      const int vb0 = (4 * hi + vq) * 128 + (4 * vx + 2 * vg + (vp >> 1)) * 16 + 8 * (vp & 1);
#pragma unroll
      for (int d0 = 0; d0 < 2; ++d0) { vofs[d0] = vb0 ^ (64 * d0); asm volatile("" : "+v"(vofs[d0])); } }
#define PV_ISSUE(ti) do { const int t_ = t0 + (ti); const bf16 *Kt, *Vt; \
        if (u.kind == 1) { if (t_ < 16) { Kt = P.CKA + (size_t)(u.b * PAST + 64 * t_) * WA; Vt = P.CVA + (size_t)(u.b * PAST + 64 * t_) * WA; } else { Kt = P.KA + (size_t)(MP + u.b * DSEQ) * WA; Vt = P.VA + (size_t)(MP + u.b * DSEQ) * WA; } } \
        else { if (t_ < 16) { Kt = P.CKB + (size_t)(u.b * BANDC + 64 * (t_ - 8)) * WA; Vt = P.CVB + (size_t)(u.b * BANDC + 64 * (t_ - 8)) * WA; } else { Kt = P.KB + (size_t)(MP + u.b * DSEQ) * WA; Vt = P.VB + (size_t)(MP + u.b * DSEQ) * WA; } } \
        int ln_ = lane_in; asm volatile("" : "+v"(ln_)); \
        const unsigned rowoff_ = (unsigned)((ln_ >> 3) * WA + h * 64); \
        const bf16* ks_ = Kt + rowoff_ + (((ln_ & 7) ^ (ln_ >> 3)) * 8); const bf16* vs_ = Vt + rowoff_ + (((ln_ & 7) ^ (4 * ((ln_ >> 4) & 1))) * 8); \
        const unsigned sd_ = (unsigned)__builtin_amdgcn_readfirstlane((int)lds_addr(lds + ((ti) % NSTP) * STP_BYTES)); \
        _Pragma("unroll") for (int i_ = 0; i_ < 8; ++i_) glds16(ks_ + i_ * 8 * WA, sd_ + i_ * 1024); \
        _Pragma("unroll") for (int i_ = 0; i_ < 8; ++i_) glds16(vs_ + i_ * 8 * WA, sd_ + 8192 + i_ * 1024); \
        if (HAS_MASK) glds16(mk_base + (size_t)t_ * 64 + ln_ * 2, sd_ + 16384); \
    } while (0)
#define PV_WALK(INIT, STEP) do { \
    INIT; \
    asm volatile("s_waitcnt vmcnt(0) lgkmcnt(0)" ::: "memory"); \
    QR_OPAQUE(); \
    for (int ti = 0; ti < NSTP - 1 && ti < nt; ++ti) PV_ISSUE(ti); \
    for (int ti = 0; ti < nt; ++ti) { \
        if (ti + NSTP - 2 <= nt - 1) { if (HAS_MASK) asm volatile("s_waitcnt vmcnt(17)" ::: "memory"); else asm volatile("s_waitcnt vmcnt(16)" ::: "memory"); } \
        else asm volatile("s_waitcnt vmcnt(0)" ::: "memory"); \
        asm volatile("s_waitcnt lgkmcnt(0)" ::: "memory");                \
        if (ti + NSTP - 1 < nt) PV_ISSUE(ti + NSTP - 1); \
        const int t = t0 + ti; \
        const LAS unsigned char* st = lds + (ti % NSTP) * STP_BYTES; \
        u64 m0 = ~0ull, m1 = ~0ull; \
        if (HAS_MASK) { int ln = lane_in; asm volatile("" : "+v"(ln)); const LAS u64* ms = (const LAS u64*)(st + 16384); m0 = ms[ln & 31]; m1 = ms[32 + (ln & 31)]; } \
        STEP; \
    } } while (0)
#define PV_ZERO() do { _Pragma("unroll") for (int a_ = 0; a_ < 2; ++a_) _Pragma("unroll") for (int b_ = 0; b_ < 2; ++b_) _Pragma("unroll") for (int r_ = 0; r_ < 16; ++r_) o[a_][b_][r_] = 0.f; \
    _Pragma("unroll") for (int r_ = 0; r_ < 16; ++r_) { L[0][r_] = 0.f; L[1][r_] = 0.f; } } while (0)
    PV_WALK(PV_ZERO(), tile_step_fast<false>(o, L, qr, st, m0, m1, HAS_MASK, t >= qc - 2, 64 * (t - qc + 3), lut, mlut, lane_in, ref, kofs, vofs));
    bool bad;
    { float lmin = L[0][0], lmax = L[0][0];
#pragma unroll
      for (int r = 0; r < 16; ++r) { lmin = __builtin_fminf(lmin, __builtin_fminf(L[0][r], L[1][r])); lmax = __builtin_fmaxf(lmax, __builtin_fmaxf(L[0][r], L[1][r])); }
      bad = !(lmin > 1e-30f && lmax < 1e30f); }
#if defined(ATT_FORCE_REDO)
    bad = true;
#endif
    if (__any(bad)) {
        PV_WALK(ref[0] = -3e38f; ref[1] = -3e38f, tile_step_max(ref, qr, st, m0, m1, HAS_MASK, t >= qc - 2, 64 * (t - qc + 3), lut, lane_in));
        ref[0] = __builtin_fmaxf(ref[0], __shfl_xor(ref[0], 32)); ref[1] = __builtin_fmaxf(ref[1], __shfl_xor(ref[1], 32));
        ref[0] = __builtin_fmaxf(ref[0], -1e30f); ref[1] = __builtin_fmaxf(ref[1], -1e30f);
        PV_WALK(PV_ZERO(), tile_step_fast<true>(o, L, qr, st, m0, m1, HAS_MASK, t >= qc - 2, 64 * (t - qc + 3), lut, mlut, lane_in, ref, kofs, vofs));
    }
#undef PV_ZERO
#undef PV_WALK
#undef PV_ISSUE
    store_o_fast(o, L, Op, lane_in);
    asm volatile("s_waitcnt vmcnt(0) lgkmcnt(0)" ::: "memory");
}

constexpr int NST = 5, ST_BYTES = 24576;
template <bool DSA, int ABL> __device__ __forceinline__ void attn_unit_shared(int b, int h, int g, const Ptrs& P, LAS unsigned char* lds, int wave, int lane_in) {
    constexpr int NP = DSA ? 3 : 2;
    const int c = 8 * g + wave;
    const int tlo = DSA ? 0 : (g > 0 ? 8 * g - 8 : 0), thi = 8 * g + 7, nt = thi - tlo + 1;
    const int wlo = DSA ? 0 : (c > 8 ? c - 8 : 0), whi = c;
    const LAS float* lut = (const LAS float*)(lds + L_LUT) + ((DSA ? 0 : 8) + h) * 256;
    const LAS u64* mlut = (const LAS u64*)(lds + L_MLUT);
    const int qrow0 = b * SEQ + 64 * c;
    const bf16* Qp = (DSA ? P.QA : P.QB) + (size_t)qrow0 * WA + h * 64;
    bf16* Op = (DSA ? P.OA : P.OB) + (size_t)qrow0 * WA + h * 64;
    const bf16* Kh = (DSA ? P.KA : P.KB) + (size_t)b * SEQ * WA + h * 64; const bf16* Vh = (DSA ? P.VA : P.VB) + (size_t)b * SEQ * WA + h * 64;
    const u64* mk_base = P.mask + (size_t)idxp::mask_tile_base(0, b, c) * 64;
    bf16x8 qr[2][4];
    { const int r32 = lane_in & 31, hi = lane_in >> 5;
#pragma unroll
    for (int qb = 0; qb < 2; ++qb)
#pragma unroll
        for (int d0 = 0; d0 < 4; ++d0) qr[qb][d0] = *(const GAS bf16x8*)(Qp + (size_t)(32 * qb + r32) * WA + d0 * 16 + hi * 8); }
    f32x16 o[2][2];
    LAS int* redo = (LAS int*)(lds + L_REDO);
    if (wave == 0 && lane_in == 0) *redo = 0;
#define SH_ISSUE(ti) do { const int t_ = tlo + (ti); int ln_ = lane_in; asm volatile("" : "+v"(ln_)); \
        const unsigned sd_ = (unsigned)__builtin_amdgcn_readfirstlane((int)lds_addr(lds + ((ti) % NST) * ST_BYTES + wave * 1024)); \
        const unsigned ro_ = (unsigned)((64 * t_ + 8 * wave) * WA * 2);       \
        glds16s(dko + ro_, Kh, sd_); \
        glds16s((dko ^ (unsigned)(((ln_ >> 3) ^ (4 * ((ln_ >> 4) & 1))) << 4)) + ro_, Vh, sd_ + 8192);     \
        if (DSA) glds16s((unsigned)(ln_ << 4) + (unsigned)((t_ < c ? t_ : c) * 512), mk_base, sd_ + 16384); \
    } while (0)
#define SH_WALK(INIT, STEP) do { \
    _Pragma("unroll") for (int a_ = 0; a_ < 2; ++a_) _Pragma("unroll") for (int b_ = 0; b_ < 2; ++b_) _Pragma("unroll") for (int r_ = 0; r_ < 16; ++r_) o[a_][b_][r_] = 0.f; \
    INIT; \
    asm volatile("s_waitcnt vmcnt(0)" ::: "memory");                       \
    QR_OPAQUE(); \
    for (int ti = 0; ti < NST - 1 && ti < nt; ++ti) SH_ISSUE(ti); \
    for (int ti = 0; ti < nt; ++ti) { \
        if (ti + NST - 2 <= nt - 1) { if (DSA) asm volatile("s_waitcnt vmcnt(6)" ::: "memory"); else asm volatile("s_waitcnt vmcnt(4)" ::: "memory"); } \
        else asm volatile("s_waitcnt vmcnt(0)" ::: "memory"); \
        asm volatile("s_waitcnt lgkmcnt(0)" ::: "memory");                \
        __builtin_amdgcn_s_barrier(); asm volatile("" ::: "memory"); \
        if (ti + NST - 1 < nt) SH_ISSUE(ti + NST - 1); \
        const int t = tlo + ti; \
        if (t >= wlo && t <= whi) { \
            const LAS unsigned char* st = lds + (ti % NST) * ST_BYTES; \
            u64 m0 = ~0ull, m1 = ~0ull; \
            if (DSA) { int ln = lane_in; asm volatile("" : "+v"(ln)); const LAS u64* ms = (const LAS u64*)(st + 16384 + wave * 1024); m0 = ms[ln & 31]; m1 = ms[32 + (ln & 31)]; } \
            STEP; \
        } \
    } } while (0)
    f32x16 L[2]; float ref[2] = {0.f, 0.f};
    unsigned dko;
    { const int ln_ = lane_in; dko = (unsigned)(((ln_ >> 3) * WA + (((ln_ & 7) ^ (ln_ >> 3)) * 8)) * 2); asm volatile("" : "+v"(dko)); }
    int kofs[4], vofs[2];
    { const int r32 = lane_in & 31, hi = lane_in >> 5, xk = (r32 >> 1) & 3, yk = hi ^ (r32 & 1);
#pragma unroll
      for (int d0 = 0; d0 < 4; ++d0) { kofs[d0] = r32 * 128 + yk * 16 + ((d0 ^ xk) * 32); asm volatile("" : "+v"(kofs[d0])); }
      const int vq = (lane_in & 15) >> 2, vp = lane_in & 3, vg = (lane_in >> 4) & 1, vx = (lane_in >> 3) & 1;
      const int vb0 = (4 * hi + vq) * 128 + (4 * vx + 2 * vg + (vp >> 1)) * 16 + 8 * (vp & 1);
#pragma unroll
      for (int d0 = 0; d0 < 2; ++d0) { vofs[d0] = vb0 ^ (64 * d0); asm volatile("" : "+v"(vofs[d0])); } }
    SH_WALK(_Pragma("unroll") for (int r_ = 0; r_ < 16; ++r_) { L[0][r_] = 0.f; L[1][r_] = 0.f; }, tile_step_fast<false>(o, L, qr, st, m0, m1, DSA, t >= c - 2, 64 * (t - c + 3), lut, mlut, lane_in, ref, kofs, vofs));
    { float lmin = L[0][0], lmax = L[0][0];
#pragma unroll
      for (int r = 0; r < 16; ++r) { lmin = __builtin_fminf(lmin, __builtin_fminf(L[0][r], L[1][r])); lmax = __builtin_fmaxf(lmax, __builtin_fmaxf(L[0][r], L[1][r])); }
      const bool bad = !(lmin > 1e-30f && lmax < 1e30f);
      if (__any(bad) && lane_in == 0) *redo = 1; }
    asm volatile("s_waitcnt vmcnt(0) lgkmcnt(0)" ::: "memory");
    __builtin_amdgcn_s_barrier(); asm volatile("" ::: "memory");
    int again = __builtin_amdgcn_readfirstlane(*redo);
#if defined(ATT_FORCE_REDO)
    again = 1;
#endif
    asm volatile("s_waitcnt lgkmcnt(0)" ::: "memory");
    __builtin_amdgcn_s_barrier(); asm volatile("" ::: "memory");
    if (again) {
        SH_WALK(ref[0] = -3e38f; ref[1] = -3e38f, tile_step_max(ref, qr, st, m0, m1, DSA, t >= c - 2, 64 * (t - c + 3), lut, lane_in));
        ref[0] = __builtin_fmaxf(ref[0], __shfl_xor(ref[0], 32)); ref[1] = __builtin_fmaxf(ref[1], __shfl_xor(ref[1], 32));
        ref[0] = __builtin_fmaxf(ref[0], -1e30f); ref[1] = __builtin_fmaxf(ref[1], -1e30f);
        asm volatile("s_waitcnt vmcnt(0) lgkmcnt(0)" ::: "memory");
        __builtin_amdgcn_s_barrier(); asm volatile("" ::: "memory");
        SH_WALK(_Pragma("unroll") for (int r_ = 0; r_ < 16; ++r_) { L[0][r_] = 0.f; L[1][r_] = 0.f; }, tile_step_fast<true>(o, L, qr, st, m0, m1, DSA, t >= c - 2, 64 * (t - c + 3), lut, mlut, lane_in, ref, kofs, vofs));
        asm volatile("s_waitcnt vmcnt(0) lgkmcnt(0)" ::: "memory");
        __builtin_amdgcn_s_barrier(); asm volatile("" ::: "memory");
    }
    if (ABL == 0) store_o_fast(o, L, Op, lane_in); else { asm volatile("" :: "v"(o[0][0]), "v"(o[0][1]), "v"(o[1][0]), "v"(o[1][1]), "v"(L[0]), "v"(L[1])); }
#undef SH_WALK
#undef SH_ISSUE
    asm volatile("s_waitcnt vmcnt(0) lgkmcnt(0)" ::: "memory");
}

template <int ABL> __device__ __forceinline__ void attn_phase(const Args& A, LAS unsigned char* lds, int vcu, int G, int wave, int lane, int tid) {
    unsigned char* ws = A.ws;
    Ptrs P; P.QA = (const bf16*)(ws + WS_QA); P.KA = (const bf16*)(ws + WS_KA); P.VA = (const bf16*)(ws + WS_VA); P.QB = (const bf16*)(ws + WS_QB); P.KB = (const bf16*)(ws + WS_KB); P.VB = (const bf16*)(ws + WS_VB);
    P.CKA = (const bf16*)(ws + WS_CKA); P.CVA = (const bf16*)(ws + WS_CVA); P.CKB = (const bf16*)(ws + WS_CKB); P.CVB = (const bf16*)(ws + WS_CVB);
    P.OA = (bf16*)(A.out + O_Y); P.OB = (bf16*)(A.out + O_Y) + (size_t)MT * WA;
    P.mask = (const u64*)(ws + WS_MASK);
    build_lut(A.in[7], A.in[15], lds, tid);
    __syncthreads();
    if (wave >= 4) __builtin_amdgcn_s_setprio(1);
    for (int j = vcu; j < 256; j += G) { const int bh = j >> 3, b = bh >> 3, h = bh & 7, g = j & 7;
        if (ABL == 0 && j < 2 * NB_S * 8) {
            __syncthreads();
            if (wave == 0) { const int sj = j & 63; AUnit u{(j < 64) ? 1 : 3, sj >> 3, 16, 0}; attn_unit_private(u, sj & 7, P, lds, wave, lane); }
            __syncthreads(); }
        attn_unit_shared<true, ABL>(b, h, 15 - g, P, lds, wave, lane);
        attn_unit_shared<true, ABL>(b, h, g, P, lds, wave, lane);
        attn_unit_shared<false, ABL>(b, h, 15 - g, P, lds, wave, lane);
        attn_unit_shared<false, ABL>(b, h, g, P, lds, wave, lane);
    }
    __builtin_amdgcn_s_setprio(0);
    __syncthreads();
}
}

__device__ __forceinline__ void mix_sample(const Args& A, LAS unsigned char* lds, int bx, int G, int wave, int lane) {
    unsigned char* ws = A.ws;
    const bf16* OA = (const bf16*)(A.out + O_Y); const bf16* OB = OA + (size_t)MT * WA;
    const bf16* WBA = (const bf16*)(ws + WS_WBA); const bf16* WBB = (const bf16*)(ws + WS_WBB);
    bf16* GA = (bf16*)(ws + WS_GA); const bf16* GB = (const bf16*)(ws + WS_GB);
    LAS float* red = (LAS float*)lds;
    const int r32 = lane & 31, hi = lane >> 5;
    for (int u = bx; u < 256; u += G) {
        const int row0 = MP + 32 * (u >> 4), col0 = 64 * (u & 15), k0 = 64 * wave;
        f32x16 acc[2][2];
#pragma unroll
        for (int br = 0; br < 2; ++br)
#pragma unroll
            for (int nb = 0; nb < 2; ++nb)
#pragma unroll
                for (int r = 0; r < 16; ++r) acc[br][nb][r] = 0.f;
#pragma unroll
        for (int br = 0; br < 2; ++br) { const bf16* O = br ? OB : OA; const bf16* W = br ? WBB : WBA;
#pragma unroll
            for (int s = 0; s < 4; ++s) { const bf16x8 a = *(const GAS bf16x8*)(O + (size_t)(row0 + r32) * WA + k0 + 16 * s + 8 * hi);
#pragma unroll
                for (int nb = 0; nb < 2; ++nb) { const bf16x8 b = *(const GAS bf16x8*)(W + (size_t)(col0 + 32 * nb + r32) * WA + k0 + 16 * s + 8 * hi);
                    acc[br][nb] = __builtin_amdgcn_mfma_f32_32x32x16_bf16(a, b, acc[br][nb], 0, 0, 0); } } }
#pragma unroll
        for (int br = 0; br < 2; ++br)
#pragma unroll
            for (int nb = 0; nb < 2; ++nb)
#pragma unroll
                for (int r = 0; r < 16; ++r) red[(wave * 64 + br * 32 + nb * 16 + r) * 64 + lane] = acc[br][nb][r];
        __syncthreads();
#pragma unroll
        for (int i = 0; i < 4; ++i) { const int rho = 4 * wave + i, nb = rho >> 4, r = rho & 15; float sa = 0.f, sb = 0.f;
#pragma unroll
            for (int w = 0; w < 8; ++w) { sa += red[(w * 64 + rho) * 64 + lane]; sb += red[(w * 64 + 32 + rho) * 64 + lane]; }
            const size_t off = (size_t)(row0 + (r & 3) + 8 * (r >> 2) + 4 * hi) * DM + col0 + 32 * nb + r32;
            const float ga = pg8::bf2f(GA[off]), gb = pg8::bf2f(GB[off]);
            GA[off] = (bf16)f2bf(ga * sa + gb * sb); }
        __syncthreads();
    }
}

__global__ void __launch_bounds__(NWAVES * 64, 2) fwd_kernel(Args args0) {
    extern __shared__ __attribute__((aligned(16))) unsigned char lds_raw[];
    LAS unsigned char* lds = (LAS unsigned char*)lds_raw;
    volatile LAS unsigned* MISC = (volatile LAS unsigned*)(lds + MISC_OFF);
    const int tid = threadIdx.x, lane = tid & 63, wave = __builtin_amdgcn_readfirstlane(tid >> 6);
    const int G = gridDim.x; const int bx = blockIdx.x; const int vcu = (G % 8 == 0) ? (bx % 8) * (G / 8) + bx / 8 : bx;
    unsigned char* ws = args0.ws;
    gu32* ctl = (gu32*)(ws + WS_CTL);
    if (tid < 64) MISC[tid] = 0u;
    __syncthreads();
    XcdBarrier bar; bar.bar = (unsigned*)(ctl + CW_BAR); bar.x = 0; bar.st = nullptr;
    if (N_LAUNCHES == 1) bar = xcd_barrier_post((unsigned*)(ctl + CW_BAR), MISC + 8);
    const int lo = args0.ph_lo, hi = args0.ph_hi;
#ifndef PH_MASK
#define PH_MASK 0xFFFF
#endif
#define IN(k) ((((PH_MASK) >> (k)) & 1) && lo <= (k) && (k) < hi)
#ifndef REP_PHASE
#define REP_PHASE -1
#endif
#define NREP(k) ((k) == REP_PHASE ? 2 : 1)
    constexpr int TAILW = (MT / 256) * (NUP / 256) % 256;
#define SEAM(k) do { if (IN(k) && IN((k) + 1)) xcd_barrier(bar); } while (0)
    const int gw = vcu * NWAVES + wave, NGW = G * NWAVES;
#define PHASE_ARGS const Args args = load_args(); unsigned char* const ws = args.ws; float* const out = args.out; bf16* const XB = (bf16*)(ws + WS_XB); bf16* const HBIG = (bf16*)(ws + WS_BIG); float* const YS = out + O_Y; (void)XB; (void)HBIG; (void)YS; (void)out

    if (IN(0)) { PHASE_ARGS; for (int rep = 0; rep < NREP(0); ++rep) { p0_prologue(args, lds, 0, vcu, G, wave, lane, tid); if (NREP(0) > 1) __syncthreads(); } }
    SEAM(0);
    if (IN(1)) for (int rep = 0; rep < NREP(1); ++rep) { PHASE_ARGS;
        pg8::Gemm g{XB, (const bf16*)(ws + WS_W1T), MT, NUP, DM}; pg8::StaticOrder S; S.init(MT, NUP, G, bx);
        pg8::EpiSwiglu E{HBIG};
        pg8::gemm_phase<pg8::EpiSwiglu, pg8::StaticOrder, true, true>(lds, g, S, E);
        if (rep == 0) { __syncthreads(); if (G > TAILW) { if (bx >= TAILW) p0_prologue(args, lds, 1, bx - TAILW, G - TAILW, wave, lane, tid); } else p0_prologue(args, lds, 1, bx, G, wave, lane, tid); __syncthreads(); }
    }
    SEAM(1);
    if (IN(2)) for (int rep = 0; rep < NREP(2); ++rep) { PHASE_ARGS;
        { pg8::Gemm g{HBIG, (const bf16*)(ws + WS_W1O), MP, DM, DFF}; pg8::StaticOrder S; S.init(MP, DM, G, bx);
          pg8::EpiResF32<0> E{args.in[0], args.in[1], nullptr, YS, ALPHA, 0.5f};
          pg8::gemm_phase<pg8::EpiResF32<0>, pg8::StaticOrder, true, true>(lds, g, S, E); }
        { pg8::Gemm g{HBIG, (const bf16*)(ws + WS_W1O), MT, DM, 256, DFF}; pg8::SplitOrder S{11, 256, bx};
          pg8::EpiSlab E{(float*)(ws + WS_GB), 256};
          pg8::gemm_phase<pg8::EpiSlab, pg8::SplitOrder, true, true>(lds, g, S, E); }
    }
    SEAM(2);
    if (IN(3)) { PHASE_ARGS; for (int rep = 0; rep < NREP(3); ++rep) { ln_pass<false>(YS, args.in[8], args.in[9], XB, nullptr, gw, NGW, lane, MP);
        ln_pass_sample<false>((const float*)(ws + WS_GB), 11, 0.5f, XB, ALPHA, args.in[8], args.in[9], XB, nullptr, gw, NGW, lane, args.in[1]); } }
    SEAM(3);
    if (IN(4)) for (int rep = 0; rep < NREP(4); ++rep) { PHASE_ARGS;
        pg8::Gemm g{XB, (const bf16*)(ws + WS_WIN), MT, NINP, DM}; pg8::StaticOrder S; S.init(MT, NINP, G, bx);
        pg8::EpiWin E{(bf16*)(ws + WS_QA), (bf16*)(ws + WS_KA), (bf16*)(ws + WS_VA), (bf16*)(ws + WS_QB), (bf16*)(ws + WS_KB), (bf16*)(ws + WS_VB), (bf16*)(ws + WS_GA), (bf16*)(ws + WS_GB),
                      (bf16*)(ws + WS_QI), (bf16*)(ws + WS_KI), (float*)(ws + WS_WX), out};
        pg8::gemm_phase<pg8::EpiWin, pg8::StaticOrder, true, true>(lds, g, S, E);
        if (rep == 0) { __syncthreads(); if (G > TAILW) { if (bx >= TAILW) p0_prologue(args, lds, 2, bx - TAILW, G - TAILW, wave, lane, tid); } else p0_prologue(args, lds, 2, bx, G, wave, lane, tid); __syncthreads(); }
    }
    SEAM(4);
#ifndef IDX_ABL
#define IDX_ABL 0
#endif
    if (IN(5)) { PHASE_ARGS; if (IDX_ABL == 0) { for (int rep = 0; rep < NREP(5); ++rep) idxp::idx_phase<0>(args, lds, vcu, G, wave, lane, tid); } else { idxp::idx_phase<0>(args, lds, vcu, G, wave, lane, tid); if (NREP(5) > 1) idxp::idx_phase<IDX_ABL>(args, lds, vcu, G, wave, lane, tid); } }
    SEAM(5);
#ifndef ATT_ABL
#define ATT_ABL 0
#endif
    if (IN(6)) { PHASE_ARGS; attp::attn_phase<0>(args, lds, vcu, G, wave, lane, tid); if (NREP(6) > 1) attp::attn_phase<ATT_ABL>(args, lds, vcu, G, wave, lane, tid); }
    SEAM(6);
    if (IN(7)) { PHASE_ARGS;
#ifndef P7_PARTS
#define P7_PARTS 3
#endif
        mix_sample(args, lds, bx, G, wave, lane);
        if (P7_PARTS & 1) { pg8::Gemm g{(const bf16*)(out + O_Y), (const bf16*)(ws + WS_WBA), MP, DM, WA}; pg8::StaticOrder S; S.init(MP, DM, G, bx);
          pg8::EpiGate<0> E{(const bf16*)(ws + WS_GA), nullptr, (bf16*)(ws + WS_KA)};
          pg8::gemm_phase<pg8::EpiGate<0>, pg8::StaticOrder, true, true>(lds, g, S, E); }
        if (P7_PARTS & 2) { pg8::Gemm g{(const bf16*)(out + O_Y) + (size_t)MT * WA, (const bf16*)(ws + WS_WBB), MP, DM, WA}; pg8::StaticOrder S; S.init(MP, DM, G, bx);
          pg8::EpiGate<1> E{(const bf16*)(ws + WS_GB), (const bf16*)(ws + WS_KA), (bf16*)(ws + WS_GA)};
          pg8::gemm_phase<pg8::EpiGate<1>, pg8::StaticOrder, true, true>(lds, g, S, E); }
    }
    SEAM(7);
    if (IN(8)) for (int rep = 0; rep < NREP(8); ++rep) { PHASE_ARGS;
        { pg8::Gemm g{(const bf16*)(ws + WS_GA), (const bf16*)(ws + WS_WOUT), MP, DM, DM}; pg8::StaticOrder S; S.init(MP, DM, G, bx);
          pg8::EpiResF32<1> E{nullptr, nullptr, XB, YS, ALPHA, 1.0f};
          pg8::gemm_phase<pg8::EpiResF32<1>, pg8::StaticOrder, true, true>(lds, g, S, E); }
        { pg8::Gemm g{(const bf16*)(ws + WS_GA), (const bf16*)(ws + WS_WOUT), MT, DM, 256, DM}; pg8::SplitOrder S{4, 256, bx};
          pg8::EpiSlab E{(float*)(ws + WS_GB), 256};
          pg8::gemm_phase<pg8::EpiSlab, pg8::SplitOrder, true, true>(lds, g, S, E); }
    }
    SEAM(8);
    if (IN(9)) { PHASE_ARGS; ln_pass<false>(YS, args.in[12], args.in[13], XB, nullptr, gw, NGW, lane, MP); ln_pass_sample<false>((const float*)(ws + WS_GB), 4, 1.0f, XB, ALPHA, args.in[12], args.in[13], XB, nullptr, gw, NGW, lane); }
    SEAM(9);
    if (IN(10)) for (int rep = 0; rep < NREP(10); ++rep) { PHASE_ARGS;
        pg8::Gemm g{XB, (const bf16*)(ws + WS_W2T), MT, NUP, DM}; pg8::StaticOrder S; S.init(MT, NUP, G, bx);
        pg8::EpiSwiglu E{HBIG};
        pg8::gemm_phase<pg8::EpiSwiglu, pg8::StaticOrder, true, true>(lds, g, S, E);
        if (rep == 0) { __syncthreads(); if (G > TAILW) { if (bx >= TAILW) p0_prologue(args, lds, 3, bx - TAILW, G - TAILW, wave, lane, tid); } else p0_prologue(args, lds, 3, bx, G, wave, lane, tid); __syncthreads(); }
    }
    SEAM(10);
    if (IN(11)) for (int rep = 0; rep < NREP(11); ++rep) { PHASE_ARGS;
        { pg8::Gemm g{HBIG, (const bf16*)(ws + WS_W2O), MP, DM, DFF}; pg8::StaticOrder S; S.init(MP, DM, G, bx);
          pg8::EpiResF32<1> E{nullptr, nullptr, XB, YS, ALPHA, 0.5f};
          pg8::gemm_phase<pg8::EpiResF32<1>, pg8::StaticOrder, true, true>(lds, g, S, E); }
        { pg8::Gemm g{HBIG, (const bf16*)(ws + WS_W2O), MT, DM, 256, DFF}; pg8::SplitOrder S{11, 256, bx};
          pg8::EpiSlab E{(float*)(ws + WS_GB), 256};
          pg8::gemm_phase<pg8::EpiSlab, pg8::SplitOrder, true, true>(lds, g, S, E); }
    }
    SEAM(11);
    if (IN(12)) { PHASE_ARGS; ln_pass<true>(YS, args.in[19], args.in[20], nullptr, YS, gw, NGW, lane, MP); ln_pass_sample<true>((const float*)(ws + WS_GB), 11, 0.5f, XB, ALPHA, args.in[19], args.in[20], nullptr, YS, gw, NGW, lane); }

#if defined(DBG_NCAND)
    if (lo <= 12 && 12 < hi) { xcd_barrier(bar); const unsigned* cw = (const unsigned*)(ws + WS_CTL); const float v = (DBG_NCAND == 1) ? sqrtf((float)cw[8]) : sqrtf(1000.0f * (float)cw[9] / (float)cw[10]);
        for (size_t i = (size_t)gw * 64 + lane; i < (size_t)MS * DM; i += (size_t)NGW * 64) YS[(size_t)MP * DM + i] = v; }
#endif
#if defined(DBG_DUMP)
    if (lo <= 12 && 12 < hi) {
        const size_t gt = (size_t)gw * 64 + lane, ngt = (size_t)NGW * 64;
        if (DBG_DUMP == 1) { const unsigned* mw = (const unsigned*)(ws + WS_MASK); for (size_t i = gt; i < (size_t)MASK_TILES * 128; i += ngt) YS[i] = (float)__builtin_popcount(mw[i]) + 0.001f * (float)(mw[i] & 1023u); }
        if (DBG_DUMP == 3) { if (gt < 4096) YS[gt] = (float)(__builtin_amdgcn_s_memrealtime() & 0xFFFFFull); }
        if (DBG_DUMP == 5) { const bf16* mx = (const bf16*)(ws + WS_KA); for (size_t i = gt; i < (size_t)MT * DM; i += ngt) YS[i] = pg8::bf2f(mx[i]); }
        if (DBG_DUMP == 4) { const bf16* mx = (const bf16*)(ws + WS_GA); for (size_t i = gt; i < (size_t)MT * DM; i += ngt) YS[i] = pg8::bf2f(mx[i]); }
        if (DBG_DUMP == 2) { const bf16* oa = (const bf16*)(ws + WS_QA); const bf16* ob = (const bf16*)(ws + WS_QB);
            for (size_t i = gt; i < (size_t)MT * WA; i += ngt) { YS[i] = pg8::bf2f(oa[i]); YS[(size_t)MT * WA + i] = pg8::bf2f(ob[i]); } }
    }
#endif
#undef IN
#undef SEAM
}

extern "C" void kernel_launch(void* const* d_in, const int* in_sizes, int n_in, void* d_out, int out_size, void* d_ws, size_t ws_size, hipStream_t stream) {
    static int grid = 0;
    if (grid == 0) {
        if (n_in != 23 || out_size != (int)O_END || ws_size < WS_END) { fprintf(stderr, "kernel_launch: unexpected shapes: n_in %d out %d ws %zu\n", n_in, out_size, ws_size); grid = -1; return; }
        int dev = 0, cus = 0;
        if (hipGetDevice(&dev) != hipSuccess || hipDeviceGetAttribute(&cus, hipDeviceAttributeMultiprocessorCount, dev) != hipSuccess) { grid = -1; return; }
        if (hipFuncSetAttribute((const void*)fwd_kernel, hipFuncAttributeMaxDynamicSharedMemorySize, LDS_BYTES) != hipSuccess) { fprintf(stderr, "kernel_launch: hipFuncSetAttribute failed\n"); grid = -1; return; }
        int per_cu = 0;
        if (hipOccupancyMaxActiveBlocksPerMultiprocessor(&per_cu, (const void*)fwd_kernel, NWAVES * 64, LDS_BYTES) != hipSuccess || per_cu < 1) fprintf(stderr, "kernel_launch: occupancy query says %d\n", per_cu);
        (void)hipGetLastError();
        grid = cus;
    }
    if (grid < 0) return;
    (void)hipMemsetAsync((char*)d_ws + WS_CTL, 0, CTL_ZERO_BYTES, stream);
    Args a{};
    for (int i = 0; i < 23; ++i) a.in[i] = (const float*)d_in[i];
    a.out = (float*)d_out; a.ws = (unsigned char*)d_ws;
    if (N_LAUNCHES == 1) { a.ph_lo = 0; a.ph_hi = N_PHASES; a.li = 0; hipLaunchKernelGGL(fwd_kernel, dim3(grid), dim3(NWAVES * 64), LDS_BYTES, stream, a); }
    else { for (int li = 0; li < N_PHASES; ++li) { a.ph_lo = li; a.ph_hi = li + 1; a.li = li; hipLaunchKernelGGL(fwd_kernel, dim3(grid), dim3(NWAVES * 64), LDS_BYTES, stream, a); } }
}
```
